# Optimizing an MI355X kernel written in HIP

```python
import jax, jax.numpy as jnp
from jax import lax
import numpy as np

D_MODEL = 1024
BATCH = 16
SEQ = 4096
DEPTH = 2

N_MIXERS = 2
N_META = 16
BLOCK = 128
N_PAD = BLOCK - N_META
BRANCH = D_MODEL
HG_DK = 128
HG_DV = 128
HG_HEADS = BRANCH // HG_DV
HG_CHUNK = BLOCK
HG_SUB = 16
N_SUB = HG_CHUNK // HG_SUB
SB_DH = 128
SB_HEADS = BRANCH // SB_DH
SB_SCALE = SB_DH ** -0.5
N_HGRN = (DEPTH + 1) // 2
N_SB = DEPTH // 2
EPS = 1e-6

kernel_name = "hybrid_hgrn2_stickbreaking_meta"


def _rmsnorm(x, w):
    xf = x.astype(jnp.float32)
    y = xf * lax.rsqrt(jnp.mean(xf * xf, axis=-1, keepdims=True) + EPS)
    return (y * w.astype(jnp.float32)).astype(x.dtype)


def _heads(t, n):
    b, l, _ = t.shape
    return t.reshape(b, l, n, -1).transpose(0, 2, 1, 3)


def _pad_front(t):
    return jnp.pad(t, ((0, 0), (0, 0), (N_PAD, 0), (0, 0)))


def _to_blocks(t):
    b, h, lp, d = t.shape
    return t.reshape(b, h, lp // BLOCK, BLOCK, d).transpose(2, 0, 1, 3, 4)


def _hgrn2_chunk(S, inp):
    q, k, v, g = inp
    bsz, h = q.shape[:2]
    b = jnp.cumsum(g, axis=2)
    o = jnp.einsum('bhtd,bhde->bhte', q * jnp.exp(b), S)
    qs = q.reshape(bsz, h, N_SUB, HG_SUB, HG_DK)
    ks = k.reshape(bsz, h, N_SUB, HG_SUB, HG_DK)
    vs = v.reshape(bsz, h, N_SUB, HG_SUB, HG_DV)
    bs = b.reshape(bsz, h, N_SUB, HG_SUB, HG_DK)
    tri = jnp.tril(jnp.ones((HG_SUB, HG_SUB), bool))[:, :, None]
    diff = bs[:, :, :, :, None, :] - bs[:, :, :, None, :, :]
    dec = jnp.exp(jnp.where(tri, diff, -jnp.inf))
    a_diag = jnp.einsum('bhntd,bhntsd,bhnsd->bhnts', qs, dec, ks)
    o_diag = jnp.einsum('bhnts,bhnse->bhnte', a_diag, vs)
    ref = jnp.concatenate([jnp.zeros_like(bs[:, :, :1, 0, :]), bs[:, :, :-1, -1, :]], axis=2)
    q_hat = qs * jnp.exp(bs - ref[:, :, :, None, :])
    lower = (jnp.arange(N_SUB)[None, :] < jnp.arange(N_SUB)[:, None])[:, :, None, None]
    expo = ref[:, :, :, None, None, :] - bs[:, :, None, :, :, :]
    k_hat = ks[:, :, None] * jnp.exp(jnp.where(lower, expo, -jnp.inf))
    a_off = jnp.einsum('bhitd,bhijsd->bhitjs', q_hat, k_hat)
    o_off = jnp.einsum('bhitjs,bhjse->bhite', a_off, vs)
    o = o + (o_diag + o_off).reshape(bsz, h, HG_CHUNK, HG_DV)
    b_last = b[:, :, -1, :]
    S = jnp.exp(b_last)[..., None] * S + jnp.einsum('bhsd,bhse->bhde', k * jnp.exp(b_last[:, :, None, :] - b), v)
    return S, o


def _hgrn2_mixer(y, w_in, lb, out_norm, w_out):
    bsz, l, _ = y.shape
    q, fz, v, gate = jnp.split(y @ w_in, 4, axis=-1)
    q, fz, v = (_heads(t, HG_HEADS).astype(jnp.float32) for t in (q, fz, v))
    lb = lb.reshape(1, HG_HEADS, 1, HG_DK)
    g = jnp.log(lb + (1.0 - lb) * jax.nn.sigmoid(fz))
    k = (1.0 - lb) * jax.nn.sigmoid(-fz)
    xs = tuple(_to_blocks(_pad_front(t)) for t in (q, k, v, g))
    s0 = jnp.zeros((bsz, HG_HEADS, HG_DK, HG_DV), jnp.float32)
    _, o = lax.scan(_hgrn2_chunk, s0, xs)
    nb = o.shape[0]
    o = o.transpose(1, 2, 0, 3, 4).reshape(bsz, HG_HEADS, nb * HG_CHUNK, HG_DV)[:, :, N_PAD:]
    o = _rmsnorm(o.transpose(0, 2, 1, 3), out_norm).reshape(bsz, l, BRANCH)
    return (o.astype(y.dtype) * jax.nn.silu(gate)) @ w_out


def _stick_breaking_mixer(y, w_in, w_out):
    bsz, l, _ = y.shape
    q, k, v, gate = jnp.split(y @ w_in, 4, axis=-1)
    q, k, v = (_pad_front(_heads(t, SB_HEADS).astype(jnp.float32)) for t in (q, k, v))
    lp = l + N_PAD
    s_pos = jnp.arange(lp)
    key_ok = s_pos >= N_PAD

    def block(args):
        qb, n = args
        t_pos = n * BLOCK + jnp.arange(BLOCK)
        valid = (s_pos[None, :] < t_pos[:, None]) & key_ok[None, :]
        z = jnp.einsum('bhtd,bhsd->bhts', qb, k) * SB_SCALE
        log_beta = jax.nn.log_sigmoid(z)
        log_keep = jnp.where(valid, log_beta - z, 0.0)
        later = lax.cumsum(log_keep, axis=3, reverse=True) - log_keep
        a = jnp.where(valid, jnp.exp(log_beta + later), 0.0)
        return jnp.einsum('bhts,bhse->bhte', a, v)

    o = lax.map(block, (_to_blocks(q), jnp.arange(lp // BLOCK)))
    o = o.transpose(1, 0, 3, 2, 4).reshape(bsz, lp, BRANCH)[:, N_PAD:]
    return (o.astype(y.dtype) * jax.nn.silu(gate)) @ w_out


def setup_inputs(seed: int = 0) -> dict:
    key = jax.random.key(seed)
    ks = jax.random.split(key, 11)
    f32 = jnp.float32
    x = jax.random.normal(ks[0], (BATCH, SEQ, D_MODEL), f32)
    meta_tokens = jax.random.normal(ks[1], (N_META, D_MODEL), f32)
    pre_norm = 1.0 + 0.05 * jax.random.normal(ks[2], (DEPTH, D_MODEL), f32)
    post_norm = 1.0 + 0.05 * jax.random.normal(ks[3], (DEPTH, D_MODEL), f32)
    hgrn_w_in = jax.random.normal(ks[4], (N_HGRN, D_MODEL, 4 * BRANCH), f32) * D_MODEL ** -0.5
    hgrn_lb = 0.5 * jax.random.normal(ks[5], (N_HGRN + 1, BRANCH), f32)
    hgrn_out_norm = 1.0 + 0.05 * jax.random.normal(ks[6], (N_HGRN, HG_DV), f32)
    hgrn_w_out = jax.random.normal(ks[7], (N_HGRN, BRANCH, D_MODEL), f32) * BRANCH ** -0.5
    sb_w_in = jax.random.normal(ks[8], (N_SB, D_MODEL, 4 * BRANCH), f32) * D_MODEL ** -0.5
    sb_w_out = jax.random.normal(ks[9], (N_SB, BRANCH, D_MODEL), f32) * BRANCH ** -0.5
    return {"x": x, "meta_tokens": meta_tokens, "pre_norm": pre_norm, "post_norm": post_norm,
            "hgrn_w_in": hgrn_w_in, "hgrn_lb": hgrn_lb, "hgrn_out_norm": hgrn_out_norm,
            "hgrn_w_out": hgrn_w_out, "sb_w_in": sb_w_in, "sb_w_out": sb_w_out}


def reference(x, meta_tokens, pre_norm, post_norm, hgrn_w_in, hgrn_lb, hgrn_out_norm, hgrn_w_out, sb_w_in, sb_w_out):
    bsz = x.shape[0]
    meta = jnp.broadcast_to(meta_tokens[None].astype(x.dtype), (bsz, N_META, D_MODEL))
    h = jnp.concatenate([meta, x], axis=1)
    lbs = jnp.cumsum(jax.nn.softmax(hgrn_lb.astype(jnp.float32), axis=0), axis=0)
    for i in range(DEPTH):
        y = _rmsnorm(h, pre_norm[i])
        j = i // N_MIXERS
        if i % N_MIXERS == 0:
            y = _hgrn2_mixer(y, hgrn_w_in[j], lbs[j], hgrn_out_norm[j], hgrn_w_out[j])
        else:
            y = _stick_breaking_mixer(y, sb_w_in[j], sb_w_out[j])
        h = h + _rmsnorm(y, post_norm[i])
    return h[:, N_META:]
```

```cpp
#include <hip/hip_runtime.h>
#include <hip/hip_cooperative_groups.h>
#include <cstdio>
namespace cg = cooperative_groups;


#define DI __device__ __forceinline__
#define LAS __attribute__((address_space(3)))
typedef unsigned short bf16_t;
typedef short bf16x8 __attribute__((ext_vector_type(8)));
typedef float f32x4 __attribute__((ext_vector_type(4)));
typedef unsigned u32x4 __attribute__((ext_vector_type(4)));
typedef unsigned u32x2 __attribute__((ext_vector_type(2)));

constexpr int D = 1024, NB = 16, SEQ = 4096, NMETA = 16, L = SEQ + NMETA, NPAD = 112, LP = L + NPAD, M = NB * L, NH = 8, DH = 128, NCHUNK = LP / 128;
constexpr float EPS = 1e-6f;
constexpr float SB_SCALE = 0.08838834764831845f;

constexpr size_t OFF_WT_IN0 = 0;
constexpr size_t OFF_WT_OUT0 = OFF_WT_IN0 + (size_t)4096 * 1024 * 2;
constexpr size_t OFF_WT_IN1 = OFF_WT_OUT0 + (size_t)1024 * 1024 * 2;
constexpr size_t OFF_WT_OUT1 = OFF_WT_IN1 + (size_t)4096 * 1024 * 2;
constexpr size_t OFF_LB = OFF_WT_OUT1 + (size_t)1024 * 1024 * 2;
constexpr size_t OFF_ABUF = OFF_LB + 4096;
constexpr size_t OFF_Q = OFF_ABUF + (size_t)M * D * 2;
constexpr size_t OFF_K = OFF_Q + (size_t)NB * LP * D * 2;
constexpr size_t OFF_V = OFF_K + (size_t)NB * LP * D * 2;
constexpr size_t OFF_GATE = OFF_V + (size_t)NB * LP * D * 2;
constexpr size_t OFF_GF = OFF_GATE + (size_t)M * D * 2;
constexpr size_t OFF_H1 = OFF_GF + (size_t)NB * LP * D * 2;
constexpr size_t WS_END = OFF_GF + (size_t)NB * LP * D * 4;
constexpr size_t OFF_BAR = WS_END + (size_t)NB * NH * NCHUNK * 128 * 4;

constexpr int MMAIN = NB * SEQ;
DI int row_of(int b, int l) { return l >= NMETA ? b * SEQ + (l - NMETA) : MMAIN + b * NMETA + l; }
DI void bl_of(int r, int& b, int& l) { if (r < MMAIN) { b = r >> 12; l = (r & (SEQ - 1)) + NMETA; } else { b = (r - MMAIN) >> 4; l = (r - MMAIN) & (NMETA - 1); } }
struct Params {
    const float *x, *meta, *pre, *post, *hw_in, *hlb, *honorm, *hw_out, *sw_in, *sw_out;
    float* out; unsigned char* ws;
};

typedef __bf16 bf16x2_t __attribute__((ext_vector_type(2)));
typedef float f32x2_t __attribute__((ext_vector_type(2)));
DI unsigned pk2(float lo, float hi) { const f32x2_t v = {lo, hi}; const bf16x2_t b = __builtin_convertvector(v, bf16x2_t); return __builtin_bit_cast(unsigned, b); }
DI int opaque_tid() { int t = threadIdx.x; asm volatile("" : "+v"(t)); return t; }
typedef _Float16 f16x2_t __attribute__((ext_vector_type(2)));
DI unsigned pkh2(float lo, float hi) { const f32x2_t v = {lo, hi}; const f16x2_t h = __builtin_convertvector(v, f16x2_t); return __builtin_bit_cast(unsigned, h); }
DI float h_lo(unsigned u) { const f16x2_t h = __builtin_bit_cast(f16x2_t, u); return (float)h[0]; }
DI float h_hi(unsigned u) { const f16x2_t h = __builtin_bit_cast(f16x2_t, u); return (float)h[1]; }
DI float bf_lo(unsigned u) { return __uint_as_float(u << 16); }
DI float bf_hi(unsigned u) { return __uint_as_float(u & 0xffff0000u); }
DI float bf2f(bf16_t u) { return __uint_as_float(((unsigned)u) << 16); }
DI float wave_sum(float v) {
#pragma unroll
    for (int o = 1; o < 64; o <<= 1) v += __shfl_xor(v, o);
    return v;
}
DI float sigmoidf_(float z) { return __builtin_amdgcn_rcpf(1.f + __expf(-z)); }

namespace pg8 {
constexpr int BM = 256, BK = 64, HALF = 128, HTB = HALF * BK * 2, STAGE_BYTES = 8 * HTB, NXCD = 8, WGM = 8;
DI int lds_byte(int r, int c) { const int st = (r >> 4) * 2 + (c >> 5), rr = r & 15, cc = c & 31, ob = rr * 64 + cc * 2; return st * 1024 + (ob ^ (((ob >> 9) & 1) << 5)); }
DI void stage_rc(int b, int& R, int& C) { const int st = b / 1024, sb = b % 1024, swz = sb ^ (((sb >> 9) & 1) << 5); R = (st >> 1) * 16 + swz / 64; C = (st & 1) * 32 + (swz % 64) / 2; }
DI int perm32(int rho) { const int n = rho >> 4, i = rho & 15; return 8 * (i >> 2) + 4 * n + (i & 3); }
struct Unit { int pm, pn; };
struct Gemm { const bf16_t* A; const bf16_t* Bt; int M, N, K; };
struct StaticOrder {
    int nM, nN, nwg, G, c;
    DI void init(int M_, int N_, int G_, int c_) { nM = M_ / BM; nN = N_ / BM; nwg = nM * nN; G = G_; c = c_; }
    DI bool next(int i, Unit& u) const {
        const long Lx = (long)i * G + c; if (Lx >= nwg) return false;
        int wgid = (int)Lx; { const int q = nwg / NXCD, r = nwg % NXCD, xcd = wgid % NXCD, off = wgid / NXCD; wgid = (xcd < r ? xcd * (q + 1) : r * (q + 1) + (xcd - r) * q) + off; }
        const int nig = WGM * nN, gid = wgid / nig, fm = gid * WGM, gsz = (nM - fm) < WGM ? (nM - fm) : WGM;
        u.pm = fm + ((wgid % nig) % gsz); u.pn = (wgid % nig) / gsz; return true;
    }
};

struct EpiBf16 {
    static constexpr bool PERM = true;
    bf16_t* O; int ldc;
    DI void operator()(const f32x4 (&acc)[2][2][4][2], const Unit& u, int wr, int wc, int fr, int fq) const {
        const int row0 = u.pm * BM + wr * 64 + fr, col0 = u.pn * BM + wc * 32 + 8 * fq;
#pragma unroll
        for (int ai = 0; ai < 2; ++ai)
#pragma unroll
            for (int m = 0; m < 4; ++m) { bf16_t* rowp = O + (size_t)(row0 + ai * HALF + m * 16) * ldc + col0;
#pragma unroll
                for (int bj = 0; bj < 2; ++bj) { const f32x4 v0 = acc[ai][bj][m][0], v1 = acc[ai][bj][m][1];
                    u32x4 w; w.x = pk2(v0[0], v0[1]); w.y = pk2(v0[2], v0[3]); w.z = pk2(v1[0], v1[1]); w.w = pk2(v1[2], v1[3]);
                    *(u32x4*)(rowp + bj * HALF) = w; } }
    }
};
struct EpiProj {
    static constexpr bool PERM = true;
    bf16_t *Q, *Kb, *V, *Gate; bf16_t* G  ; LAS const float* lb  ; int mode;
    DI void operator()(const f32x4 (&acc)[2][2][4][2], const Unit& u, int wr, int wc, int fr, int fq) const {
        const int sec = u.pn >> 2, cc0 = (u.pn & 3) * BM + wc * 32 + 8 * fq;
        float lbv[2][8];
        if (sec == 1 && mode == 0) {
#pragma unroll
            for (int bj = 0; bj < 2; ++bj) { const f32x4 a = *(LAS const f32x4*)(lb + cc0 + bj * HALF), b = *(LAS const f32x4*)(lb + cc0 + bj * HALF + 4);
                lbv[bj][0] = a[0]; lbv[bj][1] = a[1]; lbv[bj][2] = a[2]; lbv[bj][3] = a[3]; lbv[bj][4] = b[0]; lbv[bj][5] = b[1]; lbv[bj][6] = b[2]; lbv[bj][7] = b[3]; }
        }
#pragma unroll
        for (int ai = 0; ai < 2; ++ai)
#pragma unroll
            for (int m = 0; m < 4; ++m) {
                const int r = u.pm * BM + wr * 64 + fr + ai * HALF + m * 16; int b, l; bl_of(r, b, l);
                const size_t prow = (size_t)b * LP + NPAD + l;
#pragma unroll
                for (int bj = 0; bj < 2; ++bj) {
                    const int c = cc0 + bj * HALF;
                    float v[8];
#pragma unroll
                    for (int j = 0; j < 4; ++j) { v[j] = acc[ai][bj][m][0][j]; v[4 + j] = acc[ai][bj][m][1][j]; }
                    if (sec == 3) {
#pragma unroll
                        for (int j = 0; j < 8; ++j) v[j] = v[j] * sigmoidf_(v[j]);
                        u32x4 w; w.x = pk2(v[0], v[1]); w.y = pk2(v[2], v[3]); w.z = pk2(v[4], v[5]); w.w = pk2(v[6], v[7]);
                        *(u32x4*)(Gate + (size_t)r * D + c) = w;
                    } else if (sec == 1 && mode == 0) {
                        float g[8];
#pragma unroll
                        for (int j = 0; j < 8; ++j) { const float e = __expf(fminf(-v[j], 80.f)), sg = __builtin_amdgcn_rcpf(1.f + e), sn = e * sg  , lbj = lbv[bj][j];
                            g[j] = __builtin_amdgcn_logf(lbj + (1.f - lbj) * sg)  ; v[j] = (1.f - lbj) * sn; }
                        u32x4 w; w.x = pk2(v[0], v[1]); w.y = pk2(v[2], v[3]); w.z = pk2(v[4], v[5]); w.w = pk2(v[6], v[7]);
                        *(u32x4*)(Kb + prow * D + c) = w;
                        u32x4 gw; gw.x = pkh2(g[0], g[1]); gw.y = pkh2(g[2], g[3]); gw.z = pkh2(g[4], g[5]); gw.w = pkh2(g[6], g[7]);
                        *(u32x4*)(G + prow * D + c) = gw;
                    } else {
                        bf16_t* dst = Q + (size_t)sec * ((size_t)NB * LP * D);
                        u32x4 w; w.x = pk2(v[0], v[1]); w.y = pk2(v[2], v[3]); w.z = pk2(v[4], v[5]); w.w = pk2(v[6], v[7]);
                        *(u32x4*)(dst + prow * D + c) = w;
                    }
                }
            }
    }
};

template <class Epi>
DI void gemm_phase(LAS unsigned char* lds, const Gemm g, const StaticOrder& S, const Epi& E) {
    const int tid = opaque_tid(), wid = __builtin_amdgcn_readfirstlane(tid >> 6), lane = tid & 63, wr = wid >> 2, wc = wid & 3, fr = lane & 15, fq = lane >> 4;
    const int K = g.K, nt = K / BK;
    unsigned voffA[2], voffB[2];
#pragma unroll
    for (int i = 0; i < 2; ++i) { int R, C; stage_rc(tid * 16 + i * 8192, R, C); const int Rb = Epi::PERM ? ((R & ~31) + perm32(R & 31)) : R;
        voffA[i] = (unsigned)(R * K + C) * 2u; voffB[i] = (unsigned)(Rb * K + C) * 2u; }
    const size_t kstep = (size_t)(BK * 2);
    const size_t hstep = (size_t)HALF * K * 2;
    const size_t tstep = 2 * hstep;
    const unsigned ldsw = (unsigned)wid * 1024u;
    const int aoff = lds_byte(wr * 64 + fr, fq * 8), boff = lds_byte(wc * 32 + fr, fq * 8);
#define PG8_SA(b, h) (((b) * 2 + (h)) * HTB)
#define PG8_SB(b, h) ((4 + (b) * 2 + (h)) * HTB)
#define PG8_STAGE(bufoff, gbase, voff) do { _Pragma("unroll") for (int _i = 0; _i < 2; ++_i) \
        __builtin_amdgcn_global_load_lds((const unsigned*)((const char*)(gbase) + (voff)[_i]), (LAS unsigned*)(lds + (bufoff) + ldsw + _i * 8192), 16, 0, 0); } while (0)
#define PG8_LDA(dst, b, h) do { _Pragma("unroll") for (int m = 0; m < 4; ++m) _Pragma("unroll") for (int k = 0; k < 2; ++k) dst[m][k] = *(const LAS bf16x8*)(lds + PG8_SA(b, h) + aoff + m * 2048 + k * 1024); } while (0)
#define PG8_LDB(dst, b, h) do { _Pragma("unroll") for (int n = 0; n < 2; ++n) _Pragma("unroll") for (int k = 0; k < 2; ++k) dst[n][k] = *(const LAS bf16x8*)(lds + PG8_SB(b, h) + boff + n * 2048 + k * 1024); } while (0)
#define PG8_MMA(ai, bj, At, Bt) do { __builtin_amdgcn_s_setprio(1); _Pragma("unroll") for (int m = 0; m < 4; ++m) _Pragma("unroll") for (int n = 0; n < 2; ++n) _Pragma("unroll") for (int k = 0; k < 2; ++k) \
        acc[ai][bj][m][n] = __builtin_amdgcn_mfma_f32_16x16x32_bf16(Bt[n][k], At[m][k], acc[ai][bj][m][n], 0, 0, 0); __builtin_amdgcn_s_setprio(0); } while (0)
#define PG8_WAIT_V(n) asm volatile("s_waitcnt vmcnt(" #n ")" ::: "memory")
#define PG8_WAIT_L(n) asm volatile("s_waitcnt lgkmcnt(" #n ")" ::: "memory")
#define PG8_BAR __builtin_amdgcn_s_barrier()
#define PG8_SCHED __builtin_amdgcn_sched_barrier(0)
    Unit cur, nxt; int ui = 0;
    if (!S.next(0, cur)) return;
    f32x4 acc[2][2][4][2];
#pragma unroll
    for (int a = 0; a < 2; ++a)
#pragma unroll
        for (int b = 0; b < 2; ++b)
#pragma unroll
            for (int m = 0; m < 4; ++m)
#pragma unroll
                for (int n = 0; n < 2; ++n) acc[a][b][m][n] = (f32x4){0.f, 0.f, 0.f, 0.f};
    bf16x8 At[4][2], B0[2][2], B1[2][2];
    const char* cA = (const char*)g.A + (size_t)cur.pm * tstep; const char* cB = (const char*)g.Bt + (size_t)cur.pn * tstep;
    PG8_STAGE(PG8_SB(0, 0), cB, voffB); PG8_STAGE(PG8_SA(0, 0), cA, voffA); PG8_STAGE(PG8_SB(0, 1), cB + hstep, voffB); PG8_STAGE(PG8_SA(0, 1), cA + hstep, voffA);
    if (wr == 1) PG8_BAR;
    PG8_WAIT_V(4); PG8_BAR;
    PG8_STAGE(PG8_SB(1, 0), cB + kstep, voffB); PG8_STAGE(PG8_SA(1, 0), cA + kstep, voffA); PG8_STAGE(PG8_SB(1, 1), cB + hstep + kstep, voffB);
    PG8_WAIT_V(6); PG8_BAR;
    for (;;) {
        const bool has_next = S.next(ui + 1, nxt);
        const char* nA = has_next ? (const char*)g.A + (size_t)nxt.pm * tstep : cA; const char* nB = has_next ? (const char*)g.Bt + (size_t)nxt.pn * tstep : cB;
        for (int t = 0; t < nt; t += 2) {
            const bool last = (t == nt - 2);
            const char* a1 = cA + (size_t)(t + 1) * kstep;
            const char* a2 = last ? nA : cA + (size_t)(t + 2) * kstep; const char* b2 = last ? nB : cB + (size_t)(t + 2) * kstep;
            const char* a3 = a2 + kstep; const char* b3 = b2 + kstep;
            PG8_LDB(B0, 0, 0); PG8_SCHED; PG8_LDA(At, 0, 0); PG8_STAGE(PG8_SA(1, 1), a1 + hstep, voffA);
            PG8_WAIT_L(8); PG8_BAR; PG8_WAIT_L(0); PG8_MMA(0, 0, At, B0); PG8_BAR; PG8_SCHED;
            PG8_LDB(B1, 0, 1); PG8_STAGE(PG8_SB(0, 0), b2, voffB);
            PG8_BAR; PG8_WAIT_L(0); PG8_MMA(0, 1, At, B1); PG8_BAR;
            PG8_LDA(At, 0, 1); PG8_STAGE(PG8_SA(0, 0), a2, voffA);
            PG8_BAR; PG8_WAIT_L(0); PG8_MMA(1, 0, At, B0); PG8_BAR; PG8_SCHED;
            PG8_STAGE(PG8_SB(0, 1), b2 + hstep, voffB);
            PG8_WAIT_V(6); PG8_BAR; PG8_MMA(1, 1, At, B1); PG8_BAR;
            PG8_LDB(B0, 1, 0); PG8_SCHED; PG8_LDA(At, 1, 0); PG8_STAGE(PG8_SA(0, 1), a2 + hstep, voffA);
            PG8_WAIT_L(8); PG8_BAR; PG8_WAIT_L(0); PG8_MMA(0, 0, At, B0); PG8_BAR; PG8_SCHED;
            PG8_LDB(B1, 1, 1); PG8_STAGE(PG8_SB(1, 0), b3, voffB);
            PG8_BAR; PG8_WAIT_L(0); PG8_MMA(0, 1, At, B1); PG8_BAR;
            PG8_LDA(At, 1, 1); PG8_STAGE(PG8_SA(1, 0), a3, voffA);
            PG8_BAR; PG8_WAIT_L(0); PG8_MMA(1, 0, At, B0); PG8_BAR; PG8_SCHED;
            PG8_STAGE(PG8_SB(1, 1), b3 + hstep, voffB);
            PG8_WAIT_V(6); PG8_BAR; PG8_MMA(1, 1, At, B1); PG8_BAR;
        }
        E(acc, cur, wr, wc, fr, fq);
        if (!has_next) break;
#pragma unroll
        for (int a = 0; a < 2; ++a)
#pragma unroll
            for (int b = 0; b < 2; ++b)
#pragma unroll
                for (int m = 0; m < 4; ++m)
#pragma unroll
                    for (int n = 0; n < 2; ++n) acc[a][b][m][n] = (f32x4){0.f, 0.f, 0.f, 0.f};
        cur = nxt; cA = nA; cB = nB; ++ui;
    }
    PG8_WAIT_V(0);
    if (wr == 0) PG8_BAR;
    PG8_BAR;
}
}

DI void transpose_item(const float* W, int K, int N, bf16_t* WT, LAS float* scr, int item, int lane) {
    const int nblk = N / 32, kb = item / nblk, nb = item % nblk, k0 = 64 * kb, n0 = 32 * nb;
#pragma unroll 8
    for (int i = 0; i < 32; ++i) { const int kk = 2 * i + (lane >> 5); scr[kk * 33 + (lane & 31)] = W[(size_t)(k0 + kk) * N + n0 + (lane & 31)]; }
    asm volatile("s_waitcnt lgkmcnt(0)" ::: "memory");
    const int c = lane & 7;
#pragma unroll
    for (int j = 0; j < 4; ++j) { const int n = (lane >> 3) + 8 * j; const LAS float* s = scr + (8 * c) * 33 + n;
        u32x4 o; o.x = pk2(s[0 * 33], s[1 * 33]); o.y = pk2(s[2 * 33], s[3 * 33]); o.z = pk2(s[4 * 33], s[5 * 33]); o.w = pk2(s[6 * 33], s[7 * 33]);
        *(u32x4*)(WT + (size_t)(n0 + n) * K + k0 + 8 * c) = o; }
    asm volatile("s_waitcnt lgkmcnt(0)" ::: "memory");
}

DI const float* h0_row(const Params& p, int r) { return r < MMAIN ? p.x + (size_t)r * D : p.meta + (size_t)((r - MMAIN) & (NMETA - 1)) * D; }

DI void prep_phase(const Params& p, LAS unsigned char* lds) {
    const int tid = opaque_tid(), wave = tid >> 6, lane = tid & 63;
    const int gw = blockIdx.x * 8 + wave, NGW = gridDim.x * 8;
    unsigned char* ws = p.ws;
    LAS float* scr = (LAS float*)(lds + wave * 16384);
    constexpr int I_IN = (1024 / 64) * (4096 / 32), I_OUT = (1024 / 64) * (1024 / 32);
    for (int it = gw; it < 2 * I_IN + 2 * I_OUT; it += NGW) {
        int r = it;
        if (r < I_IN) { transpose_item(p.hw_in, 1024, 4096, (bf16_t*)(ws + OFF_WT_IN0), scr, r, lane); continue; } r -= I_IN;
        if (r < I_IN) { transpose_item(p.sw_in, 1024, 4096, (bf16_t*)(ws + OFF_WT_IN1), scr, r, lane); continue; } r -= I_IN;
        if (r < I_OUT) { transpose_item(p.hw_out, 1024, 1024, (bf16_t*)(ws + OFF_WT_OUT0), scr, r, lane); continue; } r -= I_OUT;
        transpose_item(p.sw_out, 1024, 1024, (bf16_t*)(ws + OFF_WT_OUT1), scr, r, lane);
    }
    const int gt = blockIdx.x * 512 + tid, NGT = gridDim.x * 512;
    for (int c = gt; c < 1024; c += NGT) ((float*)(ws + OFF_LB))[c] = 1.f / (1.f + __expf(p.hlb[1024 + c] - p.hlb[c]));
    {
        const u32x4 z = (u32x4){0u, 0u, 0u, 0u};
        constexpr int CH16 = NPAD * D * 2 / 16;
        for (int i = gt; i < NB * CH16; i += NGT) { const int b = i / CH16, o = i - b * CH16; const size_t off = (size_t)b * LP * D * 2 + (size_t)o * 16;
            *(u32x4*)(ws + OFF_Q + off) = z; *(u32x4*)(ws + OFF_K + off) = z; *(u32x4*)(ws + OFF_V + off) = z; }
        for (int i = gt; i < NB * CH16; i += NGT) { const int b = i / CH16, o = i - b * CH16; *(u32x4*)(ws + OFF_GF + (size_t)b * LP * D * 2 + (size_t)o * 16) = z; }
    }
    f32x4 wv[4];
#pragma unroll
    for (int j = 0; j < 4; ++j) wv[j] = ((const f32x4*)p.pre)[lane + 64 * j];
    f32x4 nv[4];
    if (gw < M) { const f32x4* xr = (const f32x4*)h0_row(p, gw);
#pragma unroll
        for (int j = 0; j < 4; ++j) nv[j] = xr[lane + 64 * j]; }
    for (int r = gw; r < M; r += NGW) {
        f32x4 v[4]; float s = 0.f;
#pragma unroll
        for (int j = 0; j < 4; ++j) v[j] = nv[j];
        if (r + NGW < M) { const f32x4* xn = (const f32x4*)h0_row(p, r + NGW);
#pragma unroll
            for (int j = 0; j < 4; ++j) nv[j] = xn[lane + 64 * j]; }
#pragma unroll
        for (int j = 0; j < 4; ++j) s += (v[j][0] * v[j][0] + v[j][1] * v[j][1]) + (v[j][2] * v[j][2] + v[j][3] * v[j][3]);
        const float rs = rsqrtf(wave_sum(s) * (1.f / D) + EPS);
        u32x2* o = (u32x2*)(ws + OFF_ABUF + (size_t)r * D * 2);
#pragma unroll
        for (int j = 0; j < 4; ++j) { u32x2 w; w.x = pk2(v[j][0] * rs * wv[j][0], v[j][1] * rs * wv[j][1]); w.y = pk2(v[j][2] * rs * wv[j][2], v[j][3] * rs * wv[j][3]); o[lane + 64 * j] = w; }
    }
}

namespace hg {
constexpr int RS = 272;
constexpr int R1 = 0, R2 = 128 * RS, R3 = 2 * 128 * RS, OFF_CV = 3 * 128 * RS, OFF_W = OFF_CV + 4096, OFF_PART = OFF_W + 4096, OFF_ET = OFF_PART + 4096;
constexpr size_t OFF_DEC = WS_END;
constexpr int NITEMS = NB * NH * NCHUNK;
typedef float f32x16 __attribute__((ext_vector_type(16)));
DI float expc(float x) { return __builtin_amdgcn_exp2f(fminf(x, 115.f)); }
DI int tswz(int row, int bytecol) { return row * RS + (bytecol ^ (((row >> 3) & 15) << 4)); }
DI unsigned bf_get(const u32x4& v, int j) { return (v[j >> 1] >> (16 * (j & 1))) & 0xffffu; }
DI float bf_at(const u32x4& v, int j) { return __uint_as_float((j & 1) ? (v[j >> 1] & 0xffff0000u) : (v[j >> 1] << 16)); }

DI void load_g4(const bf16_t* G  , int w, int dgrp, int rsub, u32x4 (&graw)[4]) {
    const bf16_t* gp = G + (size_t)(16 * w + 4 * rsub) * D + 8 * dgrp;
#pragma unroll
    for (int rr = 0; rr < 4; ++rr) graw[rr] = *(const u32x4*)(gp + (size_t)rr * D);
}
DI void cumsum4x8(const u32x4 (&graw)[4], int w, int dgrp, int rsub, LAS float* Wl, float (&b)[4][8], float (&blast)[8]) {
#pragma unroll
    for (int rr = 0; rr < 4; ++rr) { const u32x4 a = graw[rr];
        b[rr][0] = h_lo(a.x); b[rr][1] = h_hi(a.x); b[rr][2] = h_lo(a.y); b[rr][3] = h_hi(a.y); b[rr][4] = h_lo(a.z); b[rr][5] = h_hi(a.z); b[rr][6] = h_lo(a.w); b[rr][7] = h_hi(a.w); }
#pragma unroll
    for (int rr = 1; rr < 4; ++rr)
#pragma unroll
        for (int j = 0; j < 8; ++j) b[rr][j] += b[rr - 1][j];
    float incl[8];
#pragma unroll
    for (int j = 0; j < 8; ++j) { float x = b[3][j]; float y = __shfl_up(x, 16); x += (rsub >= 1) ? y : 0.f; y = __shfl_up(x, 32); x += (rsub >= 2) ? y : 0.f; incl[j] = x; }
    if (rsub == 3) { *(LAS f32x4*)(Wl + w * 128 + 8 * dgrp) = (f32x4){incl[0], incl[1], incl[2], incl[3]}; *(LAS f32x4*)(Wl + w * 128 + 8 * dgrp + 4) = (f32x4){incl[4], incl[5], incl[6], incl[7]}; }
    __syncthreads();
    float off[8];
#pragma unroll
    for (int j = 0; j < 8; ++j) { off[j] = incl[j] - b[3][j]; blast[j] = 0.f; }
    const int ws_ = __builtin_amdgcn_readfirstlane(w);
#pragma unroll
    for (int w2 = 0; w2 < 8; ++w2) { const f32x4 a = *(LAS const f32x4*)(Wl + w2 * 128 + 8 * dgrp), c = *(LAS const f32x4*)(Wl + w2 * 128 + 8 * dgrp + 4);
#pragma unroll
        for (int j = 0; j < 8; ++j) { const float v = j < 4 ? a[j & 3] : c[j & 3]; blast[j] += v; }
        if (w2 < ws_) {
#pragma unroll
            for (int j = 0; j < 8; ++j) off[j] += j < 4 ? a[j & 3] : c[j & 3]; } }
#pragma unroll
    for (int rr = 0; rr < 4; ++rr)
#pragma unroll
        for (int j = 0; j < 8; ++j) b[rr][j] += off[j];
}
}

DI void hgrn_phase_a(const Params& p, LAS unsigned char* lds) {
    using namespace hg;
    unsigned char* ws = p.ws;
    const int tid = opaque_tid(), w = tid >> 6, lane = tid & 63, dgrp = lane & 15, rsub = lane >> 4, r32 = lane & 31, hi = lane >> 5;
    LAS float* Wl = (LAS float*)(lds + OFF_W);
    bf16_t* Ug = (bf16_t*)p.out; float* dec = (float*)(ws + OFF_DEC);
    u32x4 gnext[4];
    { const int it2 = blockIdx.x, n = it2 & 31, bh = it2 >> 5, h = bh & 7, b = bh >> 3;
      load_g4((const bf16_t*)(ws + OFF_GF) + ((size_t)b * LP + 128 * n) * D + h * DH, w, dgrp, rsub, gnext); }
    for (int it2 = blockIdx.x; it2 < NB * NH * (NCHUNK - 1); it2 += gridDim.x) {
        const int n = it2 & 31, bh = it2 >> 5, h = bh & 7, b = bh >> 3, it = bh * NCHUNK + n;
        const size_t rowbase = ((size_t)b * LP + 128 * n) * D + h * DH;
        const bf16_t* Kg = (const bf16_t*)(ws + OFF_K) + rowbase; const bf16_t* Vg = (const bf16_t*)(ws + OFF_V) + rowbase;
        const int row0 = 16 * w + 4 * rsub;
        u32x4 graw[4];
#pragma unroll
        for (int rr = 0; rr < 4; ++rr) graw[rr] = gnext[rr];
        u32x4 kw[4], vw[4];
#pragma unroll
        for (int rr = 0; rr < 4; ++rr) { kw[rr] = *(const u32x4*)(Kg + (size_t)(row0 + rr) * D + 8 * dgrp); vw[rr] = *(const u32x4*)(Vg + (size_t)(row0 + rr) * D + 8 * dgrp); }
        __syncthreads();
        float bb[4][8], blast[8];
        cumsum4x8(graw, w, dgrp, rsub, Wl, bb, blast);
        { const int nx = it2 + (int)gridDim.x;
          if (nx < NB * NH * (NCHUNK - 1)) { const int n2 = nx & 31, bh2 = nx >> 5, h2 = bh2 & 7, b2 = bh2 >> 3;
              load_g4((const bf16_t*)(ws + OFF_GF) + ((size_t)b2 * LP + 128 * n2) * D + h2 * DH, w, dgrp, rsub, gnext); } }
#pragma unroll
        for (int j = 0; j < 8; ++j) {
            float kt[4];
#pragma unroll
            for (int rr = 0; rr < 4; ++rr) kt[rr] = bf_at(kw[rr], j) * __builtin_amdgcn_exp2f(blast[j] - bb[rr][j]);
            u32x2 kk; kk.x = pk2(kt[0], kt[1]); kk.y = pk2(kt[2], kt[3]);
            u32x2 vv; vv.x = bf_get(vw[0], j) | (bf_get(vw[1], j) << 16); vv.y = bf_get(vw[2], j) | (bf_get(vw[3], j) << 16);
            *(LAS u32x2*)(lds + R1 + tswz(8 * dgrp + j, row0 * 2)) = kk;
            *(LAS u32x2*)(lds + R2 + tswz(8 * dgrp + j, row0 * 2)) = vv;
        }
        if (w == 0 && rsub == 0) { float* dp = dec + (size_t)it * 128 + 8 * dgrp;
            *(f32x4*)dp = (f32x4){__builtin_amdgcn_exp2f(blast[0]), __builtin_amdgcn_exp2f(blast[1]), __builtin_amdgcn_exp2f(blast[2]), __builtin_amdgcn_exp2f(blast[3])};
            *(f32x4*)(dp + 4) = (f32x4){__builtin_amdgcn_exp2f(blast[4]), __builtin_amdgcn_exp2f(blast[5]), __builtin_amdgcn_exp2f(blast[6]), __builtin_amdgcn_exp2f(blast[7])}; }
        __syncthreads();
        const int I = w >> 1, et0 = 2 * (w & 1);
        f32x16 acc[2]; acc[0] = f32x16{}; acc[1] = f32x16{};
#pragma unroll
        for (int ks = 0; ks < 8; ++ks) {
            const bf16x8 a = *(LAS const bf16x8*)(lds + R1 + tswz(32 * I + r32, (16 * ks + 8 * hi) * 2));
#pragma unroll
            for (int t = 0; t < 2; ++t) { const bf16x8 vb = *(LAS const bf16x8*)(lds + R2 + tswz(32 * (et0 + t) + r32, (16 * ks + 8 * hi) * 2));
                acc[t] = __builtin_amdgcn_mfma_f32_32x32x16_bf16(a, vb, acc[t], 0, 0, 0); }
        }
        bf16_t* Uo = Ug + (size_t)it * 16384;
#pragma unroll
        for (int t = 0; t < 2; ++t)
#pragma unroll
            for (int g2 = 0; g2 < 2; ++g2) { const int e = 32 * (et0 + t) + r32;
                const unsigned a0 = pk2(acc[t][8 * g2], acc[t][8 * g2 + 1]), a1 = pk2(acc[t][8 * g2 + 2], acc[t][8 * g2 + 3]);
                const unsigned b0 = pk2(acc[t][8 * g2 + 4], acc[t][8 * g2 + 5]), b1 = pk2(acc[t][8 * g2 + 6], acc[t][8 * g2 + 7]);
                const auto s0 = __builtin_amdgcn_permlane32_swap(a0, b0, false, false), s1 = __builtin_amdgcn_permlane32_swap(a1, b1, false, false);
                u32x4 o; o.x = s0[0]; o.y = s1[0]; o.z = s0[1]; o.w = s1[1];
                *(u32x4*)(Uo + e * 128 + 32 * I + 8 * (2 * g2 + hi)) = o; }
    }
}
DI void hgrn_phase_b(const Params& p) {
    using namespace hg;
    unsigned char* ws = p.ws;
    bf16_t* Ug = (bf16_t*)p.out; const float* dec = (const float*)(ws + OFF_DEC);
    const int gt = blockIdx.x * 512 + threadIdx.x, NGT = gridDim.x * 512;
    for (int vi = gt; vi < NB * NH * 2048; vi += NGT) {
        const int bh = vi >> 11, o = (vi & 2047) * 8, d0 = o & 127;
        float S[8];
#pragma unroll
        for (int j = 0; j < 8; ++j) S[j] = 0.f;
        u32x4* ptr = (u32x4*)(Ug + (size_t)bh * NCHUNK * 16384 + o);
        const float* dp = dec + (size_t)bh * NCHUNK * 128 + d0;
#pragma unroll 1
        for (int n0 = 0; n0 < NCHUNK - 1; n0 += 8) {
            u32x4 u[8]; f32x4 da[8], db[8];
#pragma unroll
            for (int k = 0; k < 8; ++k) { u[k] = ptr[(size_t)(n0 + k) * 2048]; da[k] = *(const f32x4*)(dp + (n0 + k) * 128); db[k] = *(const f32x4*)(dp + (n0 + k) * 128 + 4); }
#pragma unroll
            for (int k = 0; k < 8; ++k) {
                u32x4 wv; wv.x = pk2(S[0], S[1]); wv.y = pk2(S[2], S[3]); wv.z = pk2(S[4], S[5]); wv.w = pk2(S[6], S[7]);
                ptr[(size_t)(n0 + k) * 2048] = wv;
                S[0] = da[k][0] * S[0] + bf_lo(u[k].x); S[1] = da[k][1] * S[1] + bf_hi(u[k].x); S[2] = da[k][2] * S[2] + bf_lo(u[k].y); S[3] = da[k][3] * S[3] + bf_hi(u[k].y);
                S[4] = db[k][0] * S[4] + bf_lo(u[k].z); S[5] = db[k][1] * S[5] + bf_hi(u[k].z); S[6] = db[k][2] * S[6] + bf_lo(u[k].w); S[7] = db[k][3] * S[7] + bf_hi(u[k].w);
            }
        }
        u32x4 wv; wv.x = pk2(S[0], S[1]); wv.y = pk2(S[2], S[3]); wv.z = pk2(S[4], S[5]); wv.w = pk2(S[6], S[7]);
        ptr[(size_t)(NCHUNK - 1) * 2048] = wv;
    }
}
DI void hgrn_phase_c(const Params& p, LAS unsigned char* lds) {
    using namespace hg;
    unsigned char* ws = p.ws;
    const int tid = opaque_tid(), w = tid >> 6, lane = tid & 63, dgrp = lane & 15, rsub = lane >> 4, l15 = lane & 15, g4 = lane >> 4;
    const int wsc = __builtin_amdgcn_readfirstlane(w);
    LAS float* Wl = (LAS float*)(lds + OFF_W); LAS float* cv = (LAS float*)(lds + OFF_CV); LAS float* part = (LAS float*)(lds + OFF_PART);
    const bf16_t* Sg = (const bf16_t*)p.out;
    const bf16_t* Gt = (const bf16_t*)(ws + OFF_GATE); bf16_t* Og = (bf16_t*)(ws + OFF_ABUF);
    const f32x4 on = *(const f32x4*)(p.honorm + 16 * w + 4 * g4);
    u32x4 gnext[4];
    { const int it = blockIdx.x, n = it % NCHUNK, bh = it / NCHUNK, h = bh & 7, b = bh >> 3;
      load_g4((const bf16_t*)(ws + OFF_GF) + ((size_t)b * LP + 128 * n) * D + h * DH, w, dgrp, rsub, gnext); }
    for (int it = blockIdx.x; it < NITEMS; it += gridDim.x) {
        const int n = it % NCHUNK, bh = it / NCHUNK, h = bh & 7, b = bh >> 3;
        const size_t rowbase = ((size_t)b * LP + 128 * n) * D + h * DH;
        const bf16_t* Qg = (const bf16_t*)(ws + OFF_Q) + rowbase; const bf16_t* Kg = (const bf16_t*)(ws + OFF_K) + rowbase; const bf16_t* Vg = (const bf16_t*)(ws + OFF_V) + rowbase;
        const bf16_t* St = Sg + (size_t)it * 16384;
        u32x4 graw[4];
#pragma unroll
        for (int rr = 0; rr < 4; ++rr) graw[rr] = gnext[rr];
        const int row0 = 16 * w + 4 * rsub;
        u32x4 qw[4], kw[4];
#pragma unroll
        for (int rr = 0; rr < 4; ++rr) { qw[rr] = *(const u32x4*)(Qg + (size_t)(row0 + rr) * D + 8 * dgrp); kw[rr] = *(const u32x4*)(Kg + (size_t)(row0 + rr) * D + 8 * dgrp); }
        __syncthreads();
        float bb[4][8], blast[8];
        cumsum4x8(graw, w, dgrp, rsub, Wl, bb, blast);
        { const int nx = it + (int)gridDim.x;
          if (nx < NITEMS) { const int n2 = nx % NCHUNK, bh2 = nx / NCHUNK, h2 = bh2 & 7, b2 = bh2 >> 3;
              load_g4((const bf16_t*)(ws + OFF_GF) + ((size_t)b2 * LP + 128 * n2) * D + h2 * DH, w, dgrp, rsub, gnext); } }
        float cc[8];
#pragma unroll
        for (int j = 0; j < 8; ++j) cc[j] = __shfl(bb[0][j], 32 + dgrp);
        if (rsub == 2) { *(LAS f32x4*)(cv + w * 128 + 8 * dgrp) = (f32x4){bb[0][0], bb[0][1], bb[0][2], bb[0][3]}; *(LAS f32x4*)(cv + w * 128 + 8 * dgrp + 4) = (f32x4){bb[0][4], bb[0][5], bb[0][6], bb[0][7]}; }
        float ec[8];
#pragma unroll
        for (int j = 0; j < 8; ++j) ec[j] = __builtin_amdgcn_exp2f(cc[j]);
        u32x4 qe[4];
#pragma unroll
        for (int rr = 0; rr < 4; ++rr) {
            float qp[8], kp[8], qx[8];
#pragma unroll
            for (int j = 0; j < 8; ++j) { const float qv = bf_at(qw[rr], j), kv = bf_at(kw[rr], j);
                const float t = __builtin_amdgcn_exp2f(__builtin_amdgcn_fmed3f(bb[rr][j] - cc[j], -115.f, 115.f));
                qp[j] = qv * t; kp[j] = kv * __builtin_amdgcn_rcpf(t); qx[j] = qp[j] * ec[j]; }
            u32x4 a; a.x = pk2(qp[0], qp[1]); a.y = pk2(qp[2], qp[3]); a.z = pk2(qp[4], qp[5]); a.w = pk2(qp[6], qp[7]);
            u32x4 c; c.x = pk2(kp[0], kp[1]); c.y = pk2(kp[2], kp[3]); c.z = pk2(kp[4], kp[5]); c.w = pk2(kp[6], kp[7]);
            *(LAS u32x4*)(lds + R1 + (row0 + rr) * RS + dgrp * 16) = a;
            *(LAS u32x4*)(lds + R2 + (row0 + rr) * RS + dgrp * 16) = c;
            qe[rr].x = pk2(qx[0], qx[1]); qe[rr].y = pk2(qx[2], qx[3]); qe[rr].z = pk2(qx[4], qx[5]); qe[rr].w = pk2(qx[6], qx[7]);
        }
        __syncthreads();
        bf16x8 sf[4]; u32x4 vw[4];
#pragma unroll
        for (int ks = 0; ks < 4; ++ks) sf[ks] = *(const bf16x8*)(St + (16 * w + l15) * 128 + 32 * ks + 8 * g4);
#pragma unroll
        for (int rr = 0; rr < 4; ++rr) vw[rr] = *(const u32x4*)(Vg + (size_t)(row0 + rr) * D + 8 * dgrp);
        {
            LAS float* et = (LAS float*)(lds + OFF_ET);
            const int dd = tid & 127;
#pragma unroll
            for (int k = 0; k < 7; ++k) {
                const int pid = (wsc >> 1) + 4 * k;
                int i = 1; while ((i + 1) * i / 2 <= pid) ++i;
                const int j = pid - i * (i - 1) / 2;
                et[pid * 128 + dd] = __builtin_amdgcn_exp2f(cv[i * 128 + dd] - cv[j * 128 + dd]);
            }
        }
        __syncthreads();
        {
            int cnt = 0;
            for (int i = 0; i < 8; ++i)
                for (int j = 0; j <= i; ++j, ++cnt) {
                    if ((cnt & 7) != wsc) continue;
                    f32x4 acc = (f32x4){0.f, 0.f, 0.f, 0.f};
#pragma unroll
                    for (int ks = 0; ks < 4; ++ks) {
                        const bf16x8 kf = *(LAS const bf16x8*)(lds + R2 + (16 * j + l15) * RS + (32 * ks + 8 * g4) * 2);
                        bf16x8 qf = *(LAS const bf16x8*)(lds + R1 + (16 * i + l15) * RS + (32 * ks + 8 * g4) * 2);
                        if (i != j) {
                            LAS const float* ep = (LAS const float*)(lds + OFF_ET) + (i * (i - 1) / 2 + j) * 128 + 32 * ks + 8 * g4;
                            const f32x4 e0 = *(LAS const f32x4*)ep, e1 = *(LAS const f32x4*)(ep + 4);
                            const u32x4 qq = __builtin_bit_cast(u32x4, qf);
                            u32x4 ow;
                            ow.x = pk2(bf_lo(qq.x) * e0[0], bf_hi(qq.x) * e0[1]);
                            ow.y = pk2(bf_lo(qq.y) * e0[2], bf_hi(qq.y) * e0[3]);
                            ow.z = pk2(bf_lo(qq.z) * e1[0], bf_hi(qq.z) * e1[1]);
                            ow.w = pk2(bf_lo(qq.w) * e1[2], bf_hi(qq.w) * e1[3]);
                            qf = __builtin_bit_cast(bf16x8, ow);
                        }
                        acc = __builtin_amdgcn_mfma_f32_16x16x32_bf16(kf, qf, acc, 0, 0, 0);
                    }
                    if (i == j) {
#pragma unroll
                        for (int jj = 0; jj < 4; ++jj) acc[jj] = (4 * g4 + jj <= l15) ? acc[jj] : 0.f;
                    }
                    u32x2 o; o.x = pk2(acc[0], acc[1]); o.y = pk2(acc[2], acc[3]);
                    *(LAS u32x2*)(lds + R3 + (16 * i + l15) * RS + (16 * j + 4 * g4) * 2) = o;
                }
            if (wsc < 4) { const int i = 2 * wsc, j = i + 1; *(LAS u32x2*)(lds + R3 + (16 * i + l15) * RS + (16 * j + 4 * g4) * 2) = (u32x2){0u, 0u}; }
        }
        __syncthreads();
#pragma unroll
        for (int rr = 0; rr < 4; ++rr) *(LAS u32x4*)(lds + R1 + (row0 + rr) * RS + dgrp * 16) = qe[rr];
#pragma unroll
        for (int j = 0; j < 8; ++j) { u32x2 vv; vv.x = bf_get(vw[0], j) | (bf_get(vw[1], j) << 16); vv.y = bf_get(vw[2], j) | (bf_get(vw[3], j) << 16);
            *(LAS u32x2*)(lds + R2 + tswz(8 * dgrp + j, row0 * 2)) = vv; }
        __syncthreads();
        const int rbase = n ? b * SEQ + 128 * (n - 1) + l15 : MMAIN + b * NMETA + l15 - 112;
        const size_t obase = (size_t)rbase * D + h * DH + 16 * w + 4 * g4;
        u32x2 gwv[8];
#pragma unroll
        for (int i = 0; i < 8; ++i) gwv[i] = *(const u32x2*)(Gt + (n || i == 7 ? obase + (size_t)(16 * i) * D : 0));
        f32x4 acc[8];
        {
            bf16x8 vf[4];
#pragma unroll
            for (int m = 0; m < 4; ++m) vf[m] = *(LAS const bf16x8*)(lds + R2 + tswz(16 * w + l15, (32 * m + 8 * g4) * 2));
#pragma unroll
            for (int i = 0; i < 8; ++i) {
                acc[i] = (f32x4){0.f, 0.f, 0.f, 0.f};
#pragma unroll
                for (int m = 0; m <= (i >> 1); ++m) { const bf16x8 bfr = *(LAS const bf16x8*)(lds + R3 + (16 * i + l15) * RS + (32 * m + 8 * g4) * 2);
                    acc[i] = __builtin_amdgcn_mfma_f32_16x16x32_bf16(vf[m], bfr, acc[i], 0, 0, 0); }
#pragma unroll
                for (int ks = 0; ks < 4; ++ks) { const bf16x8 bfr = *(LAS const bf16x8*)(lds + R1 + (16 * i + l15) * RS + (32 * ks + 8 * g4) * 2);
                    acc[i] = __builtin_amdgcn_mfma_f32_16x16x32_bf16(sf[ks], bfr, acc[i], 0, 0, 0); }
            }
            __builtin_amdgcn_sched_group_barrier(0x100, 8, 0);
#pragma unroll
            for (int k = 0; k < 52; ++k) { __builtin_amdgcn_sched_group_barrier(0x008, 1, 0); __builtin_amdgcn_sched_group_barrier(0x100, 1, 0); }
#pragma unroll
            for (int i = 0; i < 8; ++i) { float sq = (acc[i][0] * acc[i][0] + acc[i][1] * acc[i][1]) + (acc[i][2] * acc[i][2] + acc[i][3] * acc[i][3]);
                sq += __shfl_xor(sq, 16); sq += __shfl_xor(sq, 32);
                if (g4 == 0) part[(16 * i + l15) * 8 + w] = sq; }
        }
        __syncthreads();
#pragma unroll
        for (int i = 0; i < 8; ++i) {
            const f32x4 pa = *(LAS const f32x4*)(part + (16 * i + l15) * 8), pb = *(LAS const f32x4*)(part + (16 * i + l15) * 8 + 4);
            const float tot = ((pa[0] + pa[1]) + (pa[2] + pa[3])) + ((pb[0] + pb[1]) + (pb[2] + pb[3]));
            const float rs = rsqrtf(tot * (1.f / 128.f) + EPS);
            if (n || i == 7) {
                const size_t ob = obase + (size_t)(16 * i) * D;
                const u32x2 gw = gwv[i];
                u32x2 o; o.x = pk2(acc[i][0] * rs * on[0] * bf_lo(gw.x), acc[i][1] * rs * on[1] * bf_hi(gw.x));
                o.y = pk2(acc[i][2] * rs * on[2] * bf_lo(gw.y), acc[i][3] * rs * on[3] * bf_hi(gw.y));
                *(u32x2*)(Og + ob) = o;
            }
        }
    }
}

namespace sba {
typedef float f32x16 __attribute__((ext_vector_type(16)));
typedef short s16x4 __attribute__((ext_vector_type(4)));
#define KSWZ(row, colB) ((row) * 256 + ((colB) ^ (((row) & 7) << 4)))
DI int crow(int r, int hi) { return (r & 3) + 8 * (r >> 2) + 4 * hi; }
DI void qkt(f32x16& p0, f32x16& p1, LAS const unsigned char* Ks, const bf16x8* qr, int r32, int hi) {
    p0 = f32x16{}; p1 = f32x16{};
#pragma unroll
    for (int d0 = 0; d0 < 8; ++d0) { const int cb = (d0 * 16 + hi * 8) * 2;
        const bf16x8 b0 = *(LAS const bf16x8*)(Ks + KSWZ(r32, cb));
        const bf16x8 b1 = *(LAS const bf16x8*)(Ks + KSWZ(32 + r32, cb));
        p0 = __builtin_amdgcn_mfma_f32_32x32x16_bf16(b0, qr[d0], p0, 0, 0, 0);
        p1 = __builtin_amdgcn_mfma_f32_32x32x16_bf16(b1, qr[d0], p1, 0, 0, 0); }
    __builtin_amdgcn_sched_group_barrier(0x100, 8, 0);
#pragma unroll
    for (int k = 0; k < 16; ++k) { __builtin_amdgcn_sched_group_barrier(0x008, 1, 0); __builtin_amdgcn_sched_group_barrier(0x100, 1, 0); }
}
DI int v_st(int k, int c) { const int kk = (k & ~0xC) | ((k & 4) << 1) | ((k & 8) >> 1); return ((kk >> 3) * 4 + (c >> 5)) * 512 + ((kk & 7) * 32 + (c & 31)) * 2; }
DI int v_rd_base(int lane) { return ((lane & 3) << 3) | (((lane >> 2) & 3) << 6) | (((lane >> 4) & 1) << 5) | (((lane >> 5) & 1) << 8); }
constexpr int v_rd_off(int d0, int ks, int half) { return d0 * 512 + ks * 4096 + half * 2048; }
template <int OFF> DI s16x4 tr_read(int vb) { s16x4 r; asm volatile("ds_read_b64_tr_b16 %0, %1 offset:%2" : "=&v"(r) : "v"(vb), "i"(OFF) : "memory"); return r; }
template <int D0> DI void pv_one(f32x16& od, int vb, bf16x8 pa0, bf16x8 pa1, bf16x8 pa2, bf16x8 pa3) {
    const s16x4 l0 = tr_read<v_rd_off(D0, 0, 0)>(vb), h0 = tr_read<v_rd_off(D0, 0, 1)>(vb), l1 = tr_read<v_rd_off(D0, 1, 0)>(vb), h1 = tr_read<v_rd_off(D0, 1, 1)>(vb);
    const s16x4 l2 = tr_read<v_rd_off(D0, 2, 0)>(vb), h2 = tr_read<v_rd_off(D0, 2, 1)>(vb), l3 = tr_read<v_rd_off(D0, 3, 0)>(vb), h3 = tr_read<v_rd_off(D0, 3, 1)>(vb);
    asm volatile("s_waitcnt lgkmcnt(0)" ::: "memory"); __builtin_amdgcn_sched_barrier(0);
#define PK(Lx, Hx) (bf16x8){Lx[0], Lx[1], Lx[2], Lx[3], Hx[0], Hx[1], Hx[2], Hx[3]}
    od = __builtin_amdgcn_mfma_f32_32x32x16_bf16(pa0, PK(l0, h0), od, 0, 0, 0);
    od = __builtin_amdgcn_mfma_f32_32x32x16_bf16(pa1, PK(l1, h1), od, 0, 0, 0);
    od = __builtin_amdgcn_mfma_f32_32x32x16_bf16(pa2, PK(l2, h2), od, 0, 0, 0);
    od = __builtin_amdgcn_mfma_f32_32x32x16_bf16(pa3, PK(l3, h3), od, 0, 0, 0);
#undef PK
}
template <bool MASK>
DI void to_keep(f32x16& pz, int qrel  , int kmin  ) {
#pragma unroll
    for (int r = 0; r < 16; ++r) {
        const int kc = (r & 3) + 8 * (r >> 2);
        const float e = __builtin_amdgcn_exp2f(pz[r]);
        const float kp = __builtin_amdgcn_rcpf(1.f + e);
        pz[r] = (!MASK || (kc < qrel && kc >= kmin)) ? kp : 1.f;
    }
}
}

DI void attn_phase(const Params& p, LAS unsigned char* lds) {
    using namespace sba;
    unsigned char* ws = p.ws;
    const int tid = opaque_tid(), wid = tid >> 6, lane = tid & 63, r32 = lane & 31, hi = lane >> 5;
    LAS unsigned char* V_lds = lds; LAS unsigned char* K_lds = lds + 16384; LAS int* flags = (LAS int*)(lds + 32768);
    const int sr = tid >> 4, sc = (tid & 15) * 8, vst0 = v_st(sr, sc), vst1 = v_st(32 + sr, sc);
    const int vb0 = (int)(unsigned)(uintptr_t)V_lds + v_rd_base(lane);
    const bf16_t* Qg = (const bf16_t*)(ws + OFF_Q); const bf16_t* Kg = (const bf16_t*)(ws + OFF_K); const bf16_t* Vg = (const bf16_t*)(ws + OFF_V);
    const bf16_t* Gt = (const bf16_t*)(ws + OFF_GATE); bf16_t* Og = (bf16_t*)(ws + OFF_ABUF);
    constexpr int NQB = 17;
    for (int it = blockIdx.x; it < NB * NH * NQB; it += gridDim.x) {
        const int qb = it < NB * NH * (NQB - 1) ? 1 + (it & 15) : 0, bh = it < NB * NH * (NQB - 1) ? it >> 4 : it - NB * NH * (NQB - 1), h = bh & 7, b = bh >> 3;
        const int p0 = 256 * qb - 128, pw0 = p0 + 32 * wid, pq = pw0 + r32;
        const bf16_t* Kh = Kg + (size_t)b * LP * D + h * DH; const bf16_t* Vh = Vg + (size_t)b * LP * D + h * DH;
        const bf16_t* Qw = Qg + ((size_t)b * LP + (pq < 0 ? 0 : pq)) * D + h * DH + hi * 8;
        bf16x8 qr[8];
#pragma unroll
        for (int d0 = 0; d0 < 8; ++d0) { const u32x4 qv = *(const u32x4*)(Qw + d0 * 16); constexpr float C = SB_SCALE * 1.4426950408889634f;
            u32x4 qs; qs.x = pk2(bf_lo(qv.x) * C, bf_hi(qv.x) * C); qs.y = pk2(bf_lo(qv.y) * C, bf_hi(qv.y) * C); qs.z = pk2(bf_lo(qv.z) * C, bf_hi(qv.z) * C); qs.w = pk2(bf_lo(qv.w) * C, bf_hi(qv.w) * C);
            qr[d0] = __builtin_bit_cast(bf16x8, qs); }
        f32x16 o[4];
#pragma unroll
        for (int d0 = 0; d0 < 4; ++d0) o[d0] = f32x16{};
        float carry = 1.f;
        const bool wave_real = (pw0 + 31 >= NPAD);
        bool walive = wave_real;
        const int kt_hi = (p0 + 192) >> 6;
        bf16x8 v0, v1, k0, k1;
        { const size_t g0 = (size_t)(64 * kt_hi + sr) * D + sc, g1 = g0 + (size_t)32 * D;
          v0 = *(const bf16x8*)(Vh + g0); v1 = *(const bf16x8*)(Vh + g1); k0 = *(const bf16x8*)(Kh + g0); k1 = *(const bf16x8*)(Kh + g1); }
        for (int kt = kt_hi; kt >= 1; --kt) {
            __syncthreads();
            if (kt != kt_hi) {
                int any = 0;
#pragma unroll
                for (int w = 0; w < 8; ++w) any |= flags[w];
                if (!any) break;
            }
            *(LAS bf16x8*)(V_lds + vst0) = v0; *(LAS bf16x8*)(V_lds + vst1) = v1;
            *(LAS bf16x8*)(K_lds + KSWZ(sr, sc * 2)) = k0; *(LAS bf16x8*)(K_lds + KSWZ(32 + sr, sc * 2)) = k1;
            if (kt > 1) { const size_t g0 = (size_t)(64 * (kt - 1) + sr) * D + sc, g1 = g0 + (size_t)32 * D;
                v0 = *(const bf16x8*)(Vh + g0); v1 = *(const bf16x8*)(Vh + g1); k0 = *(const bf16x8*)(Kh + g0); k1 = *(const bf16x8*)(Kh + g1); }
            __syncthreads();
            if (walive && (64 * kt <= pw0 + 30)) {
                f32x16 z0, z1;
                qkt(z0, z1, K_lds, qr, r32, hi);
                const int qrel = pq - 64 * kt - 4 * hi, kmin = NPAD - 64 * kt - 4 * hi;
                if (64 * kt + 63 >= pw0 || kt == 1) { to_keep<true>(z0, qrel, kmin); to_keep<true>(z1, qrel - 32, kmin - 32); }
                else { to_keep<false>(z0, qrel, kmin); to_keep<false>(z1, qrel - 32, kmin - 32); }
                float glo[8], ghi[8];
#pragma unroll
                for (int i = 0; i < 8; ++i) {
                    const float g = i < 4 ? (z0[4 * i] * z0[4 * i + 1]) * (z0[4 * i + 2] * z0[4 * i + 3]) : (z1[4 * i - 16] * z1[4 * i - 15]) * (z1[4 * i - 14] * z1[4 * i - 13]);
                    auto rr = __builtin_amdgcn_permlane32_swap(__float_as_uint(g), __float_as_uint(g), false, false);
                    glo[i] = __uint_as_float(rr[0]); ghi[i] = __uint_as_float(rr[1]);
                }
                float R = carry;
#pragma unroll
                for (int i = 7; i >= 0; --i) {
                    float lat = hi ? R : R * ghi[i];
                    if (i >= 4) {
#pragma unroll
                        for (int j = 3; j >= 0; --j) { const float ln = lat * z1[4 * i - 16 + j]; z1[4 * i - 16 + j] = lat - ln; lat = ln; }
                    } else {
#pragma unroll
                        for (int j = 3; j >= 0; --j) { const float ln = lat * z0[4 * i + j]; z0[4 * i + j] = lat - ln; lat = ln; }
                    }
                    R = R * (glo[i] * ghi[i]);
                }
                carry = R;
                bf16x8 pa0, pa1, pa2, pa3;
#define PK4(P, BASE, OUT) do { unsigned a0 = pk2(P[BASE + 0], P[BASE + 1]), a1 = pk2(P[BASE + 2], P[BASE + 3]);   \
    unsigned b0 = pk2(P[BASE + 4], P[BASE + 5]), b1 = pk2(P[BASE + 6], P[BASE + 7]);                              \
    auto r0 = __builtin_amdgcn_permlane32_swap(a0, b0, false, false); auto r1 = __builtin_amdgcn_permlane32_swap(a1, b1, false, false); \
    u32x4 w = {r0[0], r1[0], r0[1], r1[1]}; OUT = *reinterpret_cast<bf16x8*>(&w); } while (0)
                PK4(z0, 0, pa0); PK4(z0, 8, pa1); PK4(z1, 0, pa2); PK4(z1, 8, pa3);
#undef PK4
                pv_one<0>(o[0], vb0, pa0, pa1, pa2, pa3); pv_one<1>(o[1], vb0, pa0, pa1, pa2, pa3); pv_one<2>(o[2], vb0, pa0, pa1, pa2, pa3); pv_one<3>(o[3], vb0, pa0, pa1, pa2, pa3);
            }
            {
                walive = wave_real && __any((carry > 0.f) && (pq >= NPAD));
                if (lane == 0) flags[wid] = walive ? 1 : 0;
            }
        }
        {
            LAS unsigned char* ot = lds + 40960 + wid * (32 * 272);
#pragma unroll
            for (int r = 0; r < 16; ++r)
#pragma unroll
                for (int d0 = 0; d0 < 4; ++d0) *(LAS bf16_t*)(ot + crow(r, hi) * 272 + (32 * d0 + r32) * 2) = (bf16_t)(pk2(o[d0][r], o[d0][r]) & 0xffffu);
#pragma unroll
            for (int k = 0; k < 8; ++k) {
                const int c = lane + 64 * k, row = c >> 4, ch = c & 15, pr = pw0 + row;
                if (pr >= NPAD) {
                    const u32x4 ov = *(LAS const u32x4*)(ot + row * 272 + ch * 16);
                    const size_t base = (size_t)row_of(b, pr - NPAD) * D + h * DH + ch * 8;
                    const u32x4 gv = *(const u32x4*)(Gt + base);
                    u32x4 w; w.x = pk2(bf_lo(ov.x) * bf_lo(gv.x), bf_hi(ov.x) * bf_hi(gv.x)); w.y = pk2(bf_lo(ov.y) * bf_lo(gv.y), bf_hi(ov.y) * bf_hi(gv.y));
                    w.z = pk2(bf_lo(ov.z) * bf_lo(gv.z), bf_hi(ov.z) * bf_hi(gv.z)); w.w = pk2(bf_lo(ov.w) * bf_lo(gv.w), bf_hi(ov.w) * bf_hi(gv.w));
                    *(u32x4*)(Og + base) = w;
                }
            }
        }
    }
}

DI void mid_phase(const Params& p) {
    unsigned char* ws = p.ws;
    const int tid = opaque_tid(), wave = tid >> 6, lane = tid & 63;
    const int gw = blockIdx.x * 8 + wave, NGW = gridDim.x * 8;
    f32x4 wpost[4], wpre[4];
#pragma unroll
    for (int j = 0; j < 4; ++j) { wpost[j] = ((const f32x4*)p.post)[lane + 64 * j]; wpre[j] = ((const f32x4*)(p.pre + D))[lane + 64 * j]; }
    u32x2 nyw[4]; f32x4 nhv[4];
    if (gw < M) { const u32x2* yr = (const u32x2*)((const bf16_t*)(ws + OFF_GF) + (size_t)gw * D); const f32x4* hr = (const f32x4*)h0_row(p, gw);
#pragma unroll
        for (int j = 0; j < 4; ++j) { nyw[j] = yr[lane + 64 * j]; nhv[j] = hr[lane + 64 * j]; } }
    for (int r = gw; r < M; r += NGW) {
        int b, l; bl_of(r, b, l);
        f32x4 y[4], hv[4]; float s = 0.f;
#pragma unroll
        for (int j = 0; j < 4; ++j) { const u32x2 yw = nyw[j]; y[j] = (f32x4){bf_lo(yw.x), bf_hi(yw.x), bf_lo(yw.y), bf_hi(yw.y)}; hv[j] = nhv[j]; }
        if (r + NGW < M) { const u32x2* yr = (const u32x2*)((const bf16_t*)(ws + OFF_GF) + (size_t)(r + NGW) * D); const f32x4* hr = (const f32x4*)h0_row(p, r + NGW);
#pragma unroll
            for (int j = 0; j < 4; ++j) { nyw[j] = yr[lane + 64 * j]; nhv[j] = hr[lane + 64 * j]; } }
#pragma unroll
        for (int j = 0; j < 4; ++j) s += (y[j][0] * y[j][0] + y[j][1] * y[j][1]) + (y[j][2] * y[j][2] + y[j][3] * y[j][3]);
        const float rs = rsqrtf(wave_sum(s) * (1.f / D) + EPS);
        float s1 = 0.f;
#pragma unroll
        for (int j = 0; j < 4; ++j) { hv[j] = hv[j] + y[j] * rs * wpost[j]; s1 += (hv[j][0] * hv[j][0] + hv[j][1] * hv[j][1]) + (hv[j][2] * hv[j][2] + hv[j][3] * hv[j][3]); }
        const float rs1 = rsqrtf(wave_sum(s1) * (1.f / D) + EPS);
        u32x2* o = (u32x2*)(ws + OFF_ABUF + (size_t)r * D * 2);
#pragma unroll
        for (int j = 0; j < 4; ++j) { u32x2 w; w.x = pk2(hv[j][0] * rs1 * wpre[j][0], hv[j][1] * rs1 * wpre[j][1]); w.y = pk2(hv[j][2] * rs1 * wpre[j][2], hv[j][3] * rs1 * wpre[j][3]); o[lane + 64 * j] = w; }
        if (l >= NMETA) { u32x2* hrow = (u32x2*)(ws + OFF_H1 + ((size_t)b * SEQ + (l - NMETA)) * D * 2);
#pragma unroll
            for (int j = 0; j < 4; ++j) { u32x2 hw; hw.x = pk2(hv[j][0], hv[j][1]); hw.y = pk2(hv[j][2], hv[j][3]); hrow[lane + 64 * j] = hw; } }
    }
}
DI void final_phase(const Params& p) {
    unsigned char* ws = p.ws;
    const int tid = opaque_tid(), wave = tid >> 6, lane = tid & 63;
    const int gw = blockIdx.x * 8 + wave, NGW = gridDim.x * 8;
    f32x4 wpost[4];
#pragma unroll
    for (int j = 0; j < 4; ++j) wpost[j] = ((const f32x4*)(p.post + D))[lane + 64 * j];
    u32x2 nyw[4], nhw[4];
    if (gw < NB * SEQ) { const u32x2* yr = (const u32x2*)((const bf16_t*)(ws + OFF_GF) + (size_t)gw * D); const u32x2* hrow = (const u32x2*)(ws + OFF_H1 + (size_t)gw * D * 2);
#pragma unroll
        for (int j = 0; j < 4; ++j) { nyw[j] = yr[lane + 64 * j]; nhw[j] = hrow[lane + 64 * j]; } }
    for (int r = gw; r < NB * SEQ; r += NGW) {
        f32x4* orow = (f32x4*)(p.out + (size_t)r * D);
        f32x4 y[4], hv[4]; float s = 0.f;
#pragma unroll
        for (int j = 0; j < 4; ++j) { const u32x2 yw = nyw[j]; y[j] = (f32x4){bf_lo(yw.x), bf_hi(yw.x), bf_lo(yw.y), bf_hi(yw.y)};
            const u32x2 hw = nhw[j]; hv[j] = (f32x4){bf_lo(hw.x), bf_hi(hw.x), bf_lo(hw.y), bf_hi(hw.y)}; }
        if (r + NGW < NB * SEQ) { const u32x2* yr = (const u32x2*)((const bf16_t*)(ws + OFF_GF) + (size_t)(r + NGW) * D); const u32x2* hrow = (const u32x2*)(ws + OFF_H1 + (size_t)(r + NGW) * D * 2);
#pragma unroll
            for (int j = 0; j < 4; ++j) { nyw[j] = yr[lane + 64 * j]; nhw[j] = hrow[lane + 64 * j]; } }
#pragma unroll
        for (int j = 0; j < 4; ++j) s += (y[j][0] * y[j][0] + y[j][1] * y[j][1]) + (y[j][2] * y[j][2] + y[j][3] * y[j][3]);
        const float rs = rsqrtf(wave_sum(s) * (1.f / D) + EPS);
#pragma unroll
        for (int j = 0; j < 4; ++j) orow[lane + 64 * j] = hv[j] + y[j] * rs * wpost[j];
    }
}


template <class F>
DI void meta_gemm(const bf16_t* A16, const bf16_t* Bt, int N, LAS unsigned char* lds, F&& store) {
    const int tid = opaque_tid(), wid = tid >> 6, lane = tid & 63, l15 = lane & 15, g4 = lane >> 4;
    LAS f32x4* red = (LAS f32x4*)lds;
    for (int t = blockIdx.x; t < N / 16; t += (int)gridDim.x) {
        f32x4 acc = (f32x4){0.f, 0.f, 0.f, 0.f};
        const bf16_t* bp = Bt + (size_t)(16 * t + l15) * 1024 + 8 * g4 + 128 * wid;
        const bf16_t* ap = A16 + (size_t)l15 * 1024 + 8 * g4 + 128 * wid;
#pragma unroll
        for (int ks = 0; ks < 4; ++ks) {
            const bf16x8 bf = *(const bf16x8*)(bp + 32 * ks), af = *(const bf16x8*)(ap + 32 * ks);
            acc = __builtin_amdgcn_mfma_f32_16x16x32_bf16(bf, af, acc, 0, 0, 0);
        }
        red[wid * 64 + lane] = acc;
        __syncthreads();
        if (wid == 0) {
#pragma unroll
            for (int w2 = 1; w2 < 8; ++w2) acc += red[w2 * 64 + lane];
            store(l15, 16 * t + 4 * g4, acc);
        }
        __syncthreads();
    }
}
DI void meta_proj(const Params& p, const bf16_t* Bt, int mode, LAS unsigned char* lds) {
    unsigned char* ws = p.ws;
    bf16_t* Q = (bf16_t*)(ws + OFF_Q); bf16_t* Gate = (bf16_t*)(ws + OFF_GATE); bf16_t* Gh = (bf16_t*)(ws + OFF_GF); const float* lb = (const float*)(ws + OFF_LB);
    meta_gemm((const bf16_t*)(ws + OFF_ABUF) + (size_t)MMAIN * D, Bt, 4096, lds, [&](int l, int c0, f32x4 v) {
        const int sec = c0 >> 10, cc = c0 & 1023;
        if (sec == 3) {
#pragma unroll
            for (int j = 0; j < 4; ++j) v[j] = v[j] * sigmoidf_(v[j]);
            u32x2 w; w.x = pk2(v[0], v[1]); w.y = pk2(v[2], v[3]);
            for (int b = 0; b < NB; ++b) *(u32x2*)(Gate + (size_t)row_of(b, l) * D + cc) = w;
        } else if (sec == 1 && mode == 0) {
            const f32x4 lbv = *(const f32x4*)(lb + cc);
            float g[4];
#pragma unroll
            for (int j = 0; j < 4; ++j) { const float e = __expf(fminf(-v[j], 80.f)), sg = __builtin_amdgcn_rcpf(1.f + e), sn = e * sg; g[j] = __builtin_amdgcn_logf(lbv[j] + (1.f - lbv[j]) * sg); v[j] = (1.f - lbv[j]) * sn; }
            u32x2 w; w.x = pk2(v[0], v[1]); w.y = pk2(v[2], v[3]);
            u32x2 gw; gw.x = pkh2(g[0], g[1]); gw.y = pkh2(g[2], g[3]);
            for (int b = 0; b < NB; ++b) { const size_t o = ((size_t)b * LP + NPAD + l) * D + cc; *(u32x2*)(Q + (size_t)NB * LP * D + o) = w; *(u32x2*)(Gh + o) = gw; }
        } else {
            u32x2 w; w.x = pk2(v[0], v[1]); w.y = pk2(v[2], v[3]);
            bf16_t* dst = Q + (size_t)sec * ((size_t)NB * LP * D);
            for (int b = 0; b < NB; ++b) *(u32x2*)(dst + ((size_t)b * LP + NPAD + l) * D + cc) = w;
        }
    });
}
DI void meta_out(const Params& p, const bf16_t* Bt, LAS unsigned char* lds) {
    unsigned char* ws = p.ws;
    bf16_t* Y = (bf16_t*)(ws + OFF_GF);
    meta_gemm((const bf16_t*)(ws + OFF_ABUF) + (size_t)MMAIN * D, Bt, 1024, lds, [&](int l, int c0, f32x4 v) {
        u32x2 w; w.x = pk2(v[0], v[1]); w.y = pk2(v[2], v[3]);
        for (int b = 0; b < NB; ++b) *(u32x2*)(Y + (size_t)row_of(b, l) * D + c0) = w;
    });
}

#define XB_TMO      128
#define XB_XCNT(j)  (256  + 64 * (j))
#define XB_XSUB(j)  (1280 + 64 * (j))
#define XB_XGEN(j)  (2304 + 64 * (j))
#define XB_TOP      3328
#define XB_TOPGEN   3392
#define XCD_BAR_WORDS 3456
#define XB_SPIN_CAP (1u << 20)
DI unsigned xb_ld(unsigned* p)              { return __hip_atomic_load(p, __ATOMIC_RELAXED, __HIP_MEMORY_SCOPE_AGENT); }
DI unsigned xb_add(unsigned* p, unsigned v) { return __hip_atomic_fetch_add(p, v, __ATOMIC_RELAXED, __HIP_MEMORY_SCOPE_AGENT); }
DI unsigned xb_xcc_id() { return (unsigned)__builtin_amdgcn_s_getreg((3 << 11) | 20) & 0xFu; }
#define XB_SPIN(cond, bar) do { unsigned _sp = 0; while (cond) { __builtin_amdgcn_s_sleep(1); \
    if ((++_sp & 255u) == 0u) { if (xb_ld(&(bar)[XB_TMO])) break; if (_sp > XB_SPIN_CAP) { atomicAdd(&(bar)[XB_TMO], 1u); break; } } } } while (0)
struct XcdBarrier { unsigned* bar; unsigned x; volatile LAS unsigned* st; };
DI XcdBarrier xcd_barrier_post(unsigned* bar, volatile LAS unsigned* st) {
    XcdBarrier b; b.bar = bar; b.x = xb_xcc_id(); b.st = st;
    if (threadIdx.x == 0) (void)xb_add(&bar[XB_XCNT(b.x)], 1u);
    return b;
}
DI void xcd_barrier_complete(unsigned* bar, unsigned x, unsigned& nloc, unsigned& nx) {
    const unsigned G = gridDim.x * gridDim.y * gridDim.z;
    unsigned sum, cnt, mine, sp = 0u;
    for (;;) {
        sum = 0u; cnt = 0u; mine = 0u;
#pragma unroll
        for (unsigned j = 0; j < 16; ++j) { const unsigned c = xb_ld(&bar[XB_XCNT(j)]); sum += c; cnt += (c > 0u) ? 1u : 0u; mine = (j == x) ? c : mine; }
        if (sum == G) break;
        __builtin_amdgcn_s_sleep(1);
        if ((++sp & 255u) == 0u) { if (xb_ld(&bar[XB_TMO])) break; if (sp > XB_SPIN_CAP) { atomicAdd(&bar[XB_TMO], 1u); break; } }
    }
    nloc = mine > 0u ? mine : 1u; nx = cnt > 0u ? cnt : 1u;
}
DI void xcd_barrier(const XcdBarrier& b) {
    asm volatile("s_waitcnt vmcnt(0)" ::: "memory");
    __syncthreads();
    if (threadIdx.x == 0) {
        unsigned* bar = b.bar;
        __builtin_amdgcn_s_waitcnt(0);
        unsigned nloc = b.st[0], nx = b.st[1];
        if (nloc == 0u) { xcd_barrier_complete(bar, b.x, nloc, nx); b.st[0] = nloc; b.st[1] = nx; }
        const unsigned old = xb_add(&bar[XB_XSUB(b.x)], 1u);
        const unsigned gen = old / nloc;
        if (old + 1u == (gen + 1u) * nloc) {
            __builtin_amdgcn_fence(__ATOMIC_RELEASE, "agent");
            asm volatile("s_waitcnt vmcnt(0)" ::: "memory");
            const unsigned og = xb_add(&bar[XB_TOP], 1u);
            const unsigned tg = og / nx;
            if (og + 1u == (tg + 1u) * nx) xb_add(&bar[XB_TOPGEN], 1u);
            else XB_SPIN(xb_ld(&bar[XB_TOPGEN]) == tg, bar);
            __builtin_amdgcn_fence(__ATOMIC_ACQUIRE, "agent");
            xb_add(&bar[XB_XGEN(b.x)], 1u);
            asm volatile("s_waitcnt vmcnt(0)" ::: "memory");
        } else {
            XB_SPIN(xb_ld(&bar[XB_XGEN(b.x)]) == gen, bar);
            __builtin_amdgcn_fence(__ATOMIC_ACQUIRE, "agent");
            asm volatile("s_waitcnt vmcnt(0)" ::: "memory");
        }
    }
    __syncthreads();
}

__global__ __launch_bounds__(512, 2) void mega_fwd(Params p) {
    extern __shared__ __attribute__((aligned(16))) unsigned char shm[];
    LAS unsigned char* lds = (LAS unsigned char*)shm;
    cg::grid_group grid = cg::this_grid();
    unsigned char* ws = p.ws;
    pg8::StaticOrder S;

    unsigned* barw = (unsigned*)(ws + OFF_BAR);
    volatile LAS unsigned* xst = (volatile LAS unsigned*)(lds + 131072);
    if (blockIdx.x == 0) for (int i = threadIdx.x; i < XCD_BAR_WORDS; i += 512) barw[i] = 0u;
    if (threadIdx.x == 0) { xst[0] = 0u; xst[1] = 0u; }
    prep_phase(p, lds);
    grid.sync();
    const XcdBarrier xb = xcd_barrier_post(barw, xst);
    LAS float* lb_lds = (LAS float*)(lds + 131072 + 64);
    for (int i = threadIdx.x; i < 1024; i += 512) lb_lds[i] = ((const float*)(ws + OFF_LB))[i];
    __syncthreads();
    {
        meta_proj(p, (const bf16_t*)(ws + OFF_WT_IN0), 0, lds);
        pg8::Gemm g{(const bf16_t*)(ws + OFF_ABUF), (const bf16_t*)(ws + OFF_WT_IN0), MMAIN, 4096, 1024};
        pg8::EpiProj E{(bf16_t*)(ws + OFF_Q), (bf16_t*)(ws + OFF_K), (bf16_t*)(ws + OFF_V), (bf16_t*)(ws + OFF_GATE), (bf16_t*)(ws + OFF_GF), lb_lds, 0};
        S.init(MMAIN, 4096, (int)gridDim.x, (int)blockIdx.x);
        pg8::gemm_phase(lds, g, S, E);
    }
    xcd_barrier(xb);
    hgrn_phase_a(p, lds);
    xcd_barrier(xb);
    hgrn_phase_b(p);
    xcd_barrier(xb);
    hgrn_phase_c(p, lds);
    xcd_barrier(xb);
    {
        meta_out(p, (const bf16_t*)(ws + OFF_WT_OUT0), lds);
        pg8::Gemm g{(const bf16_t*)(ws + OFF_ABUF), (const bf16_t*)(ws + OFF_WT_OUT0), MMAIN, 1024, 1024};
        pg8::EpiBf16 E{(bf16_t*)(ws + OFF_GF), D};
        S.init(MMAIN, 1024, (int)gridDim.x, (int)blockIdx.x);
        pg8::gemm_phase(lds, g, S, E);
    }
    xcd_barrier(xb);
    mid_phase(p);
    xcd_barrier(xb);
    {
        meta_proj(p, (const bf16_t*)(ws + OFF_WT_IN1), 1, lds);
        pg8::Gemm g{(const bf16_t*)(ws + OFF_ABUF), (const bf16_t*)(ws + OFF_WT_IN1), MMAIN, 4096, 1024};
        pg8::EpiProj E{(bf16_t*)(ws + OFF_Q), (bf16_t*)(ws + OFF_K), (bf16_t*)(ws + OFF_V), (bf16_t*)(ws + OFF_GATE), (bf16_t*)(ws + OFF_GF), lb_lds, 1};
        S.init(MMAIN, 4096, (int)gridDim.x, (int)blockIdx.x);
        pg8::gemm_phase(lds, g, S, E);
    }
    xcd_barrier(xb);
    attn_phase(p, lds);
    xcd_barrier(xb);
    {
        pg8::Gemm g{(const bf16_t*)(ws + OFF_ABUF), (const bf16_t*)(ws + OFF_WT_OUT1), MMAIN, 1024, 1024};
        pg8::EpiBf16 E{(bf16_t*)(ws + OFF_GF), D};
        S.init(MMAIN, 1024, (int)gridDim.x, (int)blockIdx.x);
        pg8::gemm_phase(lds, g, S, E);
    }
    xcd_barrier(xb);
    final_phase(p);
}

constexpr int LDS_BYTES = 131072 + 64 + 4096;

extern "C" void kernel_launch(void* const* d_in, const int* in_sizes, int n_in, void* d_out, int out_size, void* d_ws, size_t ws_size, hipStream_t stream) {
    static int grid_blocks = 0;
    if (!grid_blocks) {
        int dev = 0, cus = 0, per_cu = 0;
        hipGetDevice(&dev);
        hipDeviceGetAttribute(&cus, hipDeviceAttributeMultiprocessorCount, dev);
        hipFuncSetAttribute((const void*)mega_fwd, hipFuncAttributeMaxDynamicSharedMemorySize, LDS_BYTES);
        hipOccupancyMaxActiveBlocksPerMultiprocessor(&per_cu, (const void*)mega_fwd, 512, LDS_BYTES);
        if (per_cu < 1) per_cu = 1;
        grid_blocks = cus * per_cu;
        if (ws_size < WS_END + (size_t)NB * NH * NCHUNK * 128 * 4) fprintf(stderr, "workspace too small: %zu\n", ws_size);
    }
    Params p{};
    p.x = (const float*)d_in[0]; p.meta = (const float*)d_in[1]; p.pre = (const float*)d_in[2]; p.post = (const float*)d_in[3];
    p.hw_in = (const float*)d_in[4]; p.hlb = (const float*)d_in[5]; p.honorm = (const float*)d_in[6]; p.hw_out = (const float*)d_in[7];
    p.sw_in = (const float*)d_in[8]; p.sw_out = (const float*)d_in[9];
    p.out = (float*)d_out; p.ws = (unsigned char*)d_ws;
    void* args[] = {&p};
    hipError_t e = hipLaunchCooperativeKernel((const void*)mega_fwd, dim3(grid_blocks), dim3(512), args, LDS_BYTES, stream);
    if (e != hipSuccess) fprintf(stderr, "cooperative launch failed: %s (grid %d)\n", hipGetErrorString(e), grid_blocks);
}
```

```cpp
#include <hip/hip_runtime.h>
#include <hip/hip_cooperative_groups.h>
#include <cstdio>
namespace cg = cooperative_groups;


#define DI __device__ __forceinline__
#define LAS __attribute__((address_space(3)))
typedef unsigned short bf16_t;
typedef short bf16x8 __attribute__((ext_vector_type(8)));
typedef float f32x4 __attribute__((ext_vector_type(4)));
typedef unsigned u32x4 __attribute__((ext_vector_type(4)));
typedef unsigned u32x2 __attribute__((ext_vector_type(2)));

constexpr int D = 1024, NB = 16, SEQ = 4096, NMETA = 16, L = SEQ + NMETA, NPAD = 112, LP = L + NPAD, M = NB * L, NH = 8, DH = 128, NCHUNK = LP / 128;
constexpr float EPS = 1e-6f;
constexpr float SB_SCALE = 0.08838834764831845f;

constexpr size_t OFF_WT_IN0 = 0;
constexpr size_t OFF_WT_OUT0 = OFF_WT_IN0 + (size_t)4096 * 1024 * 2;
constexpr size_t OFF_WT_IN1 = OFF_WT_OUT0 + (size_t)1024 * 1024 * 2;
constexpr size_t OFF_WT_OUT1 = OFF_WT_IN1 + (size_t)4096 * 1024 * 2;
constexpr size_t OFF_LB = OFF_WT_OUT1 + (size_t)1024 * 1024 * 2;
constexpr size_t OFF_ABUF = OFF_LB + 4096;
constexpr size_t OFF_Q = OFF_ABUF + (size_t)M * D * 2;
constexpr size_t OFF_K = OFF_Q + (size_t)NB * LP * D * 2;
constexpr size_t OFF_V = OFF_K + (size_t)NB * LP * D * 2;
constexpr size_t OFF_GATE = OFF_V + (size_t)NB * LP * D * 2;
constexpr size_t OFF_GF = OFF_GATE + (size_t)M * D * 2;
constexpr size_t OFF_H1 = OFF_GF + (size_t)NB * LP * D * 2;
constexpr size_t WS_END = OFF_GF + (size_t)NB * LP * D * 4;
constexpr size_t OFF_BAR = WS_END + (size_t)NB * NH * NCHUNK * 128 * 4;

constexpr int MMAIN = NB * SEQ;
DI int row_of(int b, int l) { return l >= NMETA ? b * SEQ + (l - NMETA) : MMAIN + b * NMETA + l; }
DI void bl_of(int r, int& b, int& l) { if (r < MMAIN) { b = r >> 12; l = (r & (SEQ - 1)) + NMETA; } else { b = (r - MMAIN) >> 4; l = (r - MMAIN) & (NMETA - 1); } }
struct Params {
    const float *x, *meta, *pre, *post, *hw_in, *hlb, *honorm, *hw_out, *sw_in, *sw_out;
    float* out; unsigned char* ws;
};

typedef __bf16 bf16x2_t __attribute__((ext_vector_type(2)));
typedef float f32x2_t __attribute__((ext_vector_type(2)));
DI unsigned pk2(float lo, float hi) { const f32x2_t v = {lo, hi}; const bf16x2_t b = __builtin_convertvector(v, bf16x2_t); return __builtin_bit_cast(unsigned, b); }
DI int opaque_tid() { int t = threadIdx.x; asm volatile("" : "+v"(t)); return t; }
typedef _Float16 f16x2_t __attribute__((ext_vector_type(2)));
DI unsigned pkh2(float lo, float hi) { const f32x2_t v = {lo, hi}; const f16x2_t h = __builtin_convertvector(v, f16x2_t); return __builtin_bit_cast(unsigned, h); }
DI float h_lo(unsigned u) { const f16x2_t h = __builtin_bit_cast(f16x2_t, u); return (float)h[0]; }
DI float h_hi(unsigned u) { const f16x2_t h = __builtin_bit_cast(f16x2_t, u); return (float)h[1]; }
DI float bf_lo(unsigned u) { return __uint_as_float(u << 16); }
DI float bf_hi(unsigned u) { return __uint_as_float(u & 0xffff0000u); }
DI float bf2f(bf16_t u) { return __uint_as_float(((unsigned)u) << 16); }
DI float wave_sum(float v) {
#pragma unroll
    for (int o = 1; o < 64; o <<= 1) v += __shfl_xor(v, o);
    return v;
}
DI float sigmoidf_(float z) { return __builtin_amdgcn_rcpf(1.f + __expf(-z)); }

namespace pg8 {
constexpr int BM = 256, BK = 64, HALF = 128, HTB = HALF * BK * 2, STAGE_BYTES = 8 * HTB, NXCD = 8, WGM = 8;
DI int lds_byte(int r, int c) { const int st = (r >> 4) * 2 + (c >> 5), rr = r & 15, cc = c & 31, ob = rr * 64 + cc * 2; return st * 1024 + (ob ^ (((ob >> 9) & 1) << 5)); }
DI void stage_rc(int b, int& R, int& C) { const int st = b / 1024, sb = b % 1024, swz = sb ^ (((sb >> 9) & 1) << 5); R = (st >> 1) * 16 + swz / 64; C = (st & 1) * 32 + (swz % 64) / 2; }
DI int perm32(int rho) { const int n = rho >> 4, i = rho & 15; return 8 * (i >> 2) + 4 * n + (i & 3); }
struct Unit { int pm, pn; };
struct Gemm { const bf16_t* A; const bf16_t* Bt; int M, N, K; };
struct StaticOrder {
    int nM, nN, nwg, G, c;
    DI void init(int M_, int N_, int G_, int c_) { nM = M_ / BM; nN = N_ / BM; nwg = nM * nN; G = G_; c = c_; }
    DI bool next(int i, Unit& u) const {
        const long Lx = (long)i * G + c; if (Lx >= nwg) return false;
        int wgid = (int)Lx; { const int q = nwg / NXCD, r = nwg % NXCD, xcd = wgid % NXCD, off = wgid / NXCD; wgid = (xcd < r ? xcd * (q + 1) : r * (q + 1) + (xcd - r) * q) + off; }
        const int nig = WGM * nN, gid = wgid / nig, fm = gid * WGM, gsz = (nM - fm) < WGM ? (nM - fm) : WGM;
        u.pm = fm + ((wgid % nig) % gsz); u.pn = (wgid % nig) / gsz; return true;
    }
};

struct EpiBf16 {
    static constexpr bool PERM = true;
    bf16_t* O; int ldc;
    DI void operator()(const f32x4 (&acc)[2][2][4][2], const Unit& u, int wr, int wc, int fr, int fq) const {
        const int row0 = u.pm * BM + wr * 64 + fr, col0 = u.pn * BM + wc * 32 + 8 * fq;
#pragma unroll
        for (int ai = 0; ai < 2; ++ai)
#pragma unroll
            for (int m = 0; m < 4; ++m) { bf16_t* rowp = O + (size_t)(row0 + ai * HALF + m * 16) * ldc + col0;
#pragma unroll
                for (int bj = 0; bj < 2; ++bj) { const f32x4 v0 = acc[ai][bj][m][0], v1 = acc[ai][bj][m][1];
                    u32x4 w; w.x = pk2(v0[0], v0[1]); w.y = pk2(v0[2], v0[3]); w.z = pk2(v1[0], v1[1]); w.w = pk2(v1[2], v1[3]);
                    *(u32x4*)(rowp + bj * HALF) = w; } }
    }
};
struct EpiProj {
    static constexpr bool PERM = true;
    bf16_t *Q, *Kb, *V, *Gate; bf16_t* G  ; LAS const float* lb  ; int mode;
    DI void operator()(const f32x4 (&acc)[2][2][4][2], const Unit& u, int wr, int wc, int fr, int fq) const {
        const int sec = u.pn >> 2, cc0 = (u.pn & 3) * BM + wc * 32 + 8 * fq;
        float lbv[2][8];
        if (sec == 1 && mode == 0) {
#pragma unroll
            for (int bj = 0; bj < 2; ++bj) { const f32x4 a = *(LAS const f32x4*)(lb + cc0 + bj * HALF), b = *(LAS const f32x4*)(lb + cc0 + bj * HALF + 4);
                lbv[bj][0] = a[0]; lbv[bj][1] = a[1]; lbv[bj][2] = a[2]; lbv[bj][3] = a[3]; lbv[bj][4] = b[0]; lbv[bj][5] = b[1]; lbv[bj][6] = b[2]; lbv[bj][7] = b[3]; }
        }
#pragma unroll
        for (int ai = 0; ai < 2; ++ai)
#pragma unroll
            for (int m = 0; m < 4; ++m) {
                const int r = u.pm * BM + wr * 64 + fr + ai * HALF + m * 16; int b, l; bl_of(r, b, l);
                const size_t prow = (size_t)b * LP + NPAD + l;
#pragma unroll
                for (int bj = 0; bj < 2; ++bj) {
                    const int c = cc0 + bj * HALF;
                    float v[8];
#pragma unroll
                    for (int j = 0; j < 4; ++j) { v[j] = acc[ai][bj][m][0][j]; v[4 + j] = acc[ai][bj][m][1][j]; }
                    if (sec == 3) {
#pragma unroll
                        for (int j = 0; j < 8; ++j) v[j] = v[j] * sigmoidf_(v[j]);
                        u32x4 w; w.x = pk2(v[0], v[1]); w.y = pk2(v[2], v[3]); w.z = pk2(v[4], v[5]); w.w = pk2(v[6], v[7]);
                        *(u32x4*)(Gate + (size_t)r * D + c) = w;
                    } else if (sec == 1 && mode == 0) {
                        float g[8];
#pragma unroll
                        for (int j = 0; j < 8; ++j) { const float e = __expf(fminf(-v[j], 80.f)), sg = __builtin_amdgcn_rcpf(1.f + e), sn = e * sg  , lbj = lbv[bj][j];
                            g[j] = __builtin_amdgcn_logf(lbj + (1.f - lbj) * sg)  ; v[j] = (1.f - lbj) * sn; }
                        u32x4 w; w.x = pk2(v[0], v[1]); w.y = pk2(v[2], v[3]); w.z = pk2(v[4], v[5]); w.w = pk2(v[6], v[7]);
                        *(u32x4*)(Kb + prow * D + c) = w;
                        u32x4 gw; gw.x = pkh2(g[0], g[1]); gw.y = pkh2(g[2], g[3]); gw.z = pkh2(g[4], g[5]); gw.w = pkh2(g[6], g[7]);
                        *(u32x4*)(G + prow * D + c) = gw;
                    } else {
                        bf16_t* dst = Q + (size_t)sec * ((size_t)NB * LP * D);
                        u32x4 w; w.x = pk2(v[0], v[1]); w.y = pk2(v[2], v[3]); w.z = pk2(v[4], v[5]); w.w = pk2(v[6], v[7]);
                        *(u32x4*)(dst + prow * D + c) = w;
                    }
                }
            }
    }
};

template <class Epi>
DI void gemm_phase(LAS unsigned char* lds, const Gemm g, const StaticOrder& S, const Epi& E) {
    const int tid = opaque_tid(), wid = __builtin_amdgcn_readfirstlane(tid >> 6), lane = tid & 63, wr = wid >> 2, wc = wid & 3, fr = lane & 15, fq = lane >> 4;
    const int K = g.K, nt = K / BK;
    unsigned voffA[2], voffB[2];
#pragma unroll
    for (int i = 0; i < 2; ++i) { int R, C; stage_rc(tid * 16 + i * 8192, R, C); const int Rb = Epi::PERM ? ((R & ~31) + perm32(R & 31)) : R;
        voffA[i] = (unsigned)(R * K + C) * 2u; voffB[i] = (unsigned)(Rb * K + C) * 2u; }
    const size_t kstep = (size_t)(BK * 2);
    const size_t hstep = (size_t)HALF * K * 2;
    const size_t tstep = 2 * hstep;
    const unsigned ldsw = (unsigned)wid * 1024u;
    const int aoff = lds_byte(wr * 64 + fr, fq * 8), boff = lds_byte(wc * 32 + fr, fq * 8);
#define PG8_SA(b, h) (((b) * 2 + (h)) * HTB)
#define PG8_SB(b, h) ((4 + (b) * 2 + (h)) * HTB)
#define PG8_STAGE(bufoff, gbase, voff) do { _Pragma("unroll") for (int _i = 0; _i < 2; ++_i) \
        __builtin_amdgcn_global_load_lds((const unsigned*)((const char*)(gbase) + (voff)[_i]), (LAS unsigned*)(lds + (bufoff) + ldsw + _i * 8192), 16, 0, 0); } while (0)
#define PG8_LDA(dst, b, h) do { _Pragma("unroll") for (int m = 0; m < 4; ++m) _Pragma("unroll") for (int k = 0; k < 2; ++k) dst[m][k] = *(const LAS bf16x8*)(lds + PG8_SA(b, h) + aoff + m * 2048 + k * 1024); } while (0)
#define PG8_LDB(dst, b, h) do { _Pragma("unroll") for (int n = 0; n < 2; ++n) _Pragma("unroll") for (int k = 0; k < 2; ++k) dst[n][k] = *(const LAS bf16x8*)(lds + PG8_SB(b, h) + boff + n * 2048 + k * 1024); } while (0)
#define PG8_MMA(ai, bj, At, Bt) do { __builtin_amdgcn_s_setprio(1); _Pragma("unroll") for (int m = 0; m < 4; ++m) _Pragma("unroll") for (int n = 0; n < 2; ++n) _Pragma("unroll") for (int k = 0; k < 2; ++k) \
        acc[ai][bj][m][n] = __builtin_amdgcn_mfma_f32_16x16x32_bf16(Bt[n][k], At[m][k], acc[ai][bj][m][n], 0, 0, 0); __builtin_amdgcn_s_setprio(0); } while (0)
#define PG8_WAIT_V(n) asm volatile("s_waitcnt vmcnt(" #n ")" ::: "memory")
#define PG8_WAIT_L(n) asm volatile("s_waitcnt lgkmcnt(" #n ")" ::: "memory")
#define PG8_BAR __builtin_amdgcn_s_barrier()
#define PG8_SCHED __builtin_amdgcn_sched_barrier(0)
    Unit cur, nxt; int ui = 0;
    if (!S.next(0, cur)) return;
    f32x4 acc[2][2][4][2];
#pragma unroll
    for (int a = 0; a < 2; ++a)
#pragma unroll
        for (int b = 0; b < 2; ++b)
#pragma unroll
            for (int m = 0; m < 4; ++m)
#pragma unroll
                for (int n = 0; n < 2; ++n) acc[a][b][m][n] = (f32x4){0.f, 0.f, 0.f, 0.f};
    bf16x8 At[4][2], B0[2][2], B1[2][2];
    const char* cA = (const char*)g.A + (size_t)cur.pm * tstep; const char* cB = (const char*)g.Bt + (size_t)cur.pn * tstep;
    PG8_STAGE(PG8_SB(0, 0), cB, voffB); PG8_STAGE(PG8_SA(0, 0), cA, voffA); PG8_STAGE(PG8_SB(0, 1), cB + hstep, voffB); PG8_STAGE(PG8_SA(0, 1), cA + hstep, voffA);
    if (wr == 1) PG8_BAR;
    PG8_WAIT_V(4); PG8_BAR;
    PG8_STAGE(PG8_SB(1, 0), cB + kstep, voffB); PG8_STAGE(PG8_SA(1, 0), cA + kstep, voffA); PG8_STAGE(PG8_SB(1, 1), cB + hstep + kstep, voffB);
    PG8_WAIT_V(6); PG8_BAR;
    for (;;) {
        const bool has_next = S.next(ui + 1, nxt);
        const char* nA = has_next ? (const char*)g.A + (size_t)nxt.pm * tstep : cA; const char* nB = has_next ? (const char*)g.Bt + (size_t)nxt.pn * tstep : cB;
        for (int t = 0; t < nt; t += 2) {
            const bool last = (t == nt - 2);
            const char* a1 = cA + (size_t)(t + 1) * kstep;
            const char* a2 = last ? nA : cA + (size_t)(t + 2) * kstep; const char* b2 = last ? nB : cB + (size_t)(t + 2) * kstep;
            const char* a3 = a2 + kstep; const char* b3 = b2 + kstep;
            PG8_LDB(B0, 0, 0); PG8_SCHED; PG8_LDA(At, 0, 0); PG8_STAGE(PG8_SA(1, 1), a1 + hstep, voffA);
            PG8_WAIT_L(8); PG8_BAR; PG8_WAIT_L(0); PG8_MMA(0, 0, At, B0); PG8_BAR; PG8_SCHED;
            PG8_LDB(B1, 0, 1); PG8_STAGE(PG8_SB(0, 0), b2, voffB);
            PG8_BAR; PG8_WAIT_L(0); PG8_MMA(0, 1, At, B1); PG8_BAR;
            PG8_LDA(At, 0, 1); PG8_STAGE(PG8_SA(0, 0), a2, voffA);
            PG8_BAR; PG8_WAIT_L(0); PG8_MMA(1, 0, At, B0); PG8_BAR; PG8_SCHED;
            PG8_STAGE(PG8_SB(0, 1), b2 + hstep, voffB);
            PG8_WAIT_V(6); PG8_BAR; PG8_MMA(1, 1, At, B1); PG8_BAR;
            PG8_LDB(B0, 1, 0); PG8_SCHED; PG8_LDA(At, 1, 0); PG8_STAGE(PG8_SA(0, 1), a2 + hstep, voffA);
            PG8_WAIT_L(8); PG8_BAR; PG8_WAIT_L(0); PG8_MMA(0, 0, At, B0); PG8_BAR; PG8_SCHED;
            PG8_LDB(B1, 1, 1); PG8_STAGE(PG8_SB(1, 0), b3, voffB);
            PG8_BAR; PG8_WAIT_L(0); PG8_MMA(0, 1, At, B1); PG8_BAR;
            PG8_LDA(At, 1, 1); PG8_STAGE(PG8_SA(1, 0), a3, voffA);
            PG8_BAR; PG8_WAIT_L(0); PG8_MMA(1, 0, At, B0); PG8_BAR; PG8_SCHED;
            PG8_STAGE(PG8_SB(1, 1), b3 + hstep, voffB);
            PG8_WAIT_V(6); PG8_BAR; PG8_MMA(1, 1, At, B1); PG8_BAR;
        }
        E(acc, cur, wr, wc, fr, fq);
        if (!has_next) break;
#pragma unroll
        for (int a = 0; a < 2; ++a)
#pragma unroll
            for (int b = 0; b < 2; ++b)
#pragma unroll
                for (int m = 0; m < 4; ++m)
#pragma unroll
                    for (int n = 0; n < 2; ++n) acc[a][b][m][n] = (f32x4){0.f, 0.f, 0.f, 0.f};
        cur = nxt; cA = nA; cB = nB; ++ui;
    }
    PG8_WAIT_V(0);
    if (wr == 0) PG8_BAR;
    PG8_BAR;
}
}

DI void transpose_item(const float* W, int K, int N, bf16_t* WT, LAS float* scr, int item, int lane) {
    const int nblk = N / 32, kb = item / nblk, nb = item % nblk, k0 = 64 * kb, n0 = 32 * nb;
#pragma unroll 8
    for (int i = 0; i < 32; ++i) { const int kk = 2 * i + (lane >> 5); scr[kk * 33 + (lane & 31)] = W[(size_t)(k0 + kk) * N + n0 + (lane & 31)]; }
    asm volatile("s_waitcnt lgkmcnt(0)" ::: "memory");
    const int c = lane & 7;
#pragma unroll
    for (int j = 0; j < 4; ++j) { const int n = (lane >> 3) + 8 * j; const LAS float* s = scr + (8 * c) * 33 + n;
        u32x4 o; o.x = pk2(s[0 * 33], s[1 * 33]); o.y = pk2(s[2 * 33], s[3 * 33]); o.z = pk2(s[4 * 33], s[5 * 33]); o.w = pk2(s[6 * 33], s[7 * 33]);
        *(u32x4*)(WT + (size_t)(n0 + n) * K + k0 + 8 * c) = o; }
    asm volatile("s_waitcnt lgkmcnt(0)" ::: "memory");
}

DI const float* h0_row(const Params& p, int r) { return r < MMAIN ? p.x + (size_t)r * D : p.meta + (size_t)((r - MMAIN) & (NMETA - 1)) * D; }

DI void prep_phase(const Params& p, LAS unsigned char* lds) {
    const int tid = opaque_tid(), wave = tid >> 6, lane = tid & 63;
    const int gw = blockIdx.x * 8 + wave, NGW = gridDim.x * 8;
    unsigned char* ws = p.ws;
    LAS float* scr = (LAS float*)(lds + wave * 16384);
    constexpr int I_IN = (1024 / 64) * (4096 / 32), I_OUT = (1024 / 64) * (1024 / 32);
    for (int it = gw; it < 2 * I_IN + 2 * I_OUT; it += NGW) {
        int r = it;
        if (r < I_IN) { transpose_item(p.hw_in, 1024, 4096, (bf16_t*)(ws + OFF_WT_IN0), scr, r, lane); continue; } r -= I_IN;
        if (r < I_IN) { transpose_item(p.sw_in, 1024, 4096, (bf16_t*)(ws + OFF_WT_IN1), scr, r, lane); continue; } r -= I_IN;
        if (r < I_OUT) { transpose_item(p.hw_out, 1024, 1024, (bf16_t*)(ws + OFF_WT_OUT0), scr, r, lane); continue; } r -= I_OUT;
        transpose_item(p.sw_out, 1024, 1024, (bf16_t*)(ws + OFF_WT_OUT1), scr, r, lane);
    }
    const int gt = blockIdx.x * 512 + tid, NGT = gridDim.x * 512;
    for (int c = gt; c < 1024; c += NGT) ((float*)(ws + OFF_LB))[c] = 1.f / (1.f + __expf(p.hlb[1024 + c] - p.hlb[c]));
    {
        const u32x4 z = (u32x4){0u, 0u, 0u, 0u};
        constexpr int CH16 = NPAD * D * 2 / 16;
        for (int i = gt; i < NB * CH16; i += NGT) { const int b = i / CH16, o = i - b * CH16; const size_t off = (size_t)b * LP * D * 2 + (size_t)o * 16;
            *(u32x4*)(ws + OFF_Q + off) = z; *(u32x4*)(ws + OFF_K + off) = z; *(u32x4*)(ws + OFF_V + off) = z; }
        for (int i = gt; i < NB * CH16; i += NGT) { const int b = i / CH16, o = i - b * CH16; *(u32x4*)(ws + OFF_GF + (size_t)b * LP * D * 2 + (size_t)o * 16) = z; }
    }
    f32x4 wv[4];
#pragma unroll
    for (int j = 0; j < 4; ++j) wv[j] = ((const f32x4*)p.pre)[lane + 64 * j];
    f32x4 nv[4];
    if (gw < M) { const f32x4* xr = (const f32x4*)h0_row(p, gw);
#pragma unroll
        for (int j = 0; j < 4; ++j) nv[j] = xr[lane + 64 * j]; }
    for (int r = gw; r < M; r += NGW) {
        f32x4 v[4]; float s = 0.f;
#pragma unroll
        for (int j = 0; j < 4; ++j) v[j] = nv[j];
        if (r + NGW < M) { const f32x4* xn = (const f32x4*)h0_row(p, r + NGW);
#pragma unroll
            for (int j = 0; j < 4; ++j) nv[j] = xn[lane + 64 * j]; }
#pragma unroll
        for (int j = 0; j < 4; ++j) s += (v[j][0] * v[j][0] + v[j][1] * v[j][1]) + (v[j][2] * v[j][2] + v[j][3] * v[j][3]);
        const float rs = rsqrtf(wave_sum(s) * (1.f / D) + EPS);
        u32x2* o = (u32x2*)(ws + OFF_ABUF + (size_t)r * D * 2);
#pragma unroll
        for (int j = 0; j < 4; ++j) { u32x2 w; w.x = pk2(v[j][0] * rs * wv[j][0], v[j][1] * rs * wv[j][1]); w.y = pk2(v[j][2] * rs * wv[j][2], v[j][3] * rs * wv[j][3]); o[lane + 64 * j] = w; }
    }
}

namespace hg {
constexpr int RS = 272;
constexpr int R1 = 0, R2 = 128 * RS, R3 = 2 * 128 * RS, OFF_CV = 3 * 128 * RS, OFF_W = OFF_CV + 4096, OFF_PART = OFF_W + 4096, OFF_ET = OFF_PART + 4096;
constexpr size_t OFF_DEC = WS_END;
constexpr int NITEMS = NB * NH * NCHUNK;
typedef float f32x16 __attribute__((ext_vector_type(16)));
DI float expc(float x) { return __builtin_amdgcn_exp2f(fminf(x, 115.f)); }
DI int tswz(int row, int bytecol) { return row * RS + (bytecol ^ (((row >> 3) & 15) << 4)); }
DI unsigned bf_get(const u32x4& v, int j) { return (v[j >> 1] >> (16 * (j & 1))) & 0xffffu; }
DI float bf_at(const u32x4& v, int j) { return __uint_as_float((j & 1) ? (v[j >> 1] & 0xffff0000u) : (v[j >> 1] << 16)); }

DI void load_g4(const bf16_t* G  , int w, int dgrp, int rsub, u32x4 (&graw)[4]) {
    const bf16_t* gp = G + (size_t)(16 * w + 4 * rsub) * D + 8 * dgrp;
#pragma unroll
    for (int rr = 0; rr < 4; ++rr) graw[rr] = *(const u32x4*)(gp + (size_t)rr * D);
}
DI void cumsum4x8(const u32x4 (&graw)[4], int w, int dgrp, int rsub, LAS float* Wl, float (&b)[4][8], float (&blast)[8]) {
#pragma unroll
    for (int rr = 0; rr < 4; ++rr) { const u32x4 a = graw[rr];
        b[rr][0] = h_lo(a.x); b[rr][1] = h_hi(a.x); b[rr][2] = h_lo(a.y); b[rr][3] = h_hi(a.y); b[rr][4] = h_lo(a.z); b[rr][5] = h_hi(a.z); b[rr][6] = h_lo(a.w); b[rr][7] = h_hi(a.w); }
#pragma unroll
    for (int rr = 1; rr < 4; ++rr)
#pragma unroll
        for (int j = 0; j < 8; ++j) b[rr][j] += b[rr - 1][j];
    float incl[8];
#pragma unroll
    for (int j = 0; j < 8; ++j) { float x = b[3][j]; float y = __shfl_up(x, 16); x += (rsub >= 1) ? y : 0.f; y = __shfl_up(x, 32); x += (rsub >= 2) ? y : 0.f; incl[j] = x; }
    if (rsub == 3) { *(LAS f32x4*)(Wl + w * 128 + 8 * dgrp) = (f32x4){incl[0], incl[1], incl[2], incl[3]}; *(LAS f32x4*)(Wl + w * 128 + 8 * dgrp + 4) = (f32x4){incl[4], incl[5], incl[6], incl[7]}; }
    __syncthreads();
    float off[8];
#pragma unroll
    for (int j = 0; j < 8; ++j) { off[j] = incl[j] - b[3][j]; blast[j] = 0.f; }
    const int ws_ = __builtin_amdgcn_readfirstlane(w);
#pragma unroll
    for (int w2 = 0; w2 < 8; ++w2) { const f32x4 a = *(LAS const f32x4*)(Wl + w2 * 128 + 8 * dgrp), c = *(LAS const f32x4*)(Wl + w2 * 128 + 8 * dgrp + 4);
#pragma unroll
        for (int j = 0; j < 8; ++j) { const float v = j < 4 ? a[j & 3] : c[j & 3]; blast[j] += v; }
        if (w2 < ws_) {
#pragma unroll
            for (int j = 0; j < 8; ++j) off[j] += j < 4 ? a[j & 3] : c[j & 3]; } }
#pragma unroll
    for (int rr = 0; rr < 4; ++rr)
#pragma unroll
        for (int j = 0; j < 8; ++j) b[rr][j] += off[j];
}
}

DI void hgrn_phase_a(const Params& p, LAS unsigned char* lds) {
    using namespace hg;
    unsigned char* ws = p.ws;
    const int tid = opaque_tid(), w = tid >> 6, lane = tid & 63, dgrp = lane & 15, rsub = lane >> 4, r32 = lane & 31, hi = lane >> 5;
    LAS float* Wl = (LAS float*)(lds + OFF_W);
    bf16_t* Ug = (bf16_t*)p.out; float* dec = (float*)(ws + OFF_DEC);
    u32x4 gnext[4];
    { const int it2 = blockIdx.x, n = it2 & 31, bh = it2 >> 5, h = bh & 7, b = bh >> 3;
      load_g4((const bf16_t*)(ws + OFF_GF) + ((size_t)b * LP + 128 * n) * D + h * DH, w, dgrp, rsub, gnext); }
    for (int it2 = blockIdx.x; it2 < NB * NH * (NCHUNK - 1); it2 += gridDim.x) {
        const int n = it2 & 31, bh = it2 >> 5, h = bh & 7, b = bh >> 3, it = bh * NCHUNK + n;
        const size_t rowbase = ((size_t)b * LP + 128 * n) * D + h * DH;
        const bf16_t* Kg = (const bf16_t*)(ws + OFF_K) + rowbase; const bf16_t* Vg = (const bf16_t*)(ws + OFF_V) + rowbase;
        const int row0 = 16 * w + 4 * rsub;
        u32x4 graw[4];
#pragma unroll
        for (int rr = 0; rr < 4; ++rr) graw[rr] = gnext[rr];
        u32x4 kw[4], vw[4];
#pragma unroll
        for (int rr = 0; rr < 4; ++rr) { kw[rr] = *(const u32x4*)(Kg + (size_t)(row0 + rr) * D + 8 * dgrp); vw[rr] = *(const u32x4*)(Vg + (size_t)(row0 + rr) * D + 8 * dgrp); }
        __syncthreads();
        float bb[4][8], blast[8];
        cumsum4x8(graw, w, dgrp, rsub, Wl, bb, blast);
        { const int nx = it2 + (int)gridDim.x;
          if (nx < NB * NH * (NCHUNK - 1)) { const int n2 = nx & 31, bh2 = nx >> 5, h2 = bh2 & 7, b2 = bh2 >> 3;
              load_g4((const bf16_t*)(ws + OFF_GF) + ((size_t)b2 * LP + 128 * n2) * D + h2 * DH, w, dgrp, rsub, gnext); } }
#pragma unroll
        for (int j = 0; j < 8; ++j) {
            float kt[4];
#pragma unroll
            for (int rr = 0; rr < 4; ++rr) kt[rr] = bf_at(kw[rr], j) * __builtin_amdgcn_exp2f(blast[j] - bb[rr][j]);
            u32x2 kk; kk.x = pk2(kt[0], kt[1]); kk.y = pk2(kt[2], kt[3]);
            u32x2 vv; vv.x = bf_get(vw[0], j) | (bf_get(vw[1], j) << 16); vv.y = bf_get(vw[2], j) | (bf_get(vw[3], j) << 16);
            *(LAS u32x2*)(lds + R1 + tswz(8 * dgrp + j, row0 * 2)) = kk;
            *(LAS u32x2*)(lds + R2 + tswz(8 * dgrp + j, row0 * 2)) = vv;
        }
        if (w == 0 && rsub == 0) { float* dp = dec + (size_t)it * 128 + 8 * dgrp;
            *(f32x4*)dp = (f32x4){__builtin_amdgcn_exp2f(blast[0]), __builtin_amdgcn_exp2f(blast[1]), __builtin_amdgcn_exp2f(blast[2]), __builtin_amdgcn_exp2f(blast[3])};
            *(f32x4*)(dp + 4) = (f32x4){__builtin_amdgcn_exp2f(blast[4]), __builtin_amdgcn_exp2f(blast[5]), __builtin_amdgcn_exp2f(blast[6]), __builtin_amdgcn_exp2f(blast[7])}; }
        __syncthreads();
        const int I = w >> 1, et0 = 2 * (w & 1);
        f32x16 acc[2]; acc[0] = f32x16{}; acc[1] = f32x16{};
#pragma unroll
        for (int ks = 0; ks < 8; ++ks) {
            const bf16x8 a = *(LAS const bf16x8*)(lds + R1 + tswz(32 * I + r32, (16 * ks + 8 * hi) * 2));
#pragma unroll
            for (int t = 0; t < 2; ++t) { const bf16x8 vb = *(LAS const bf16x8*)(lds + R2 + tswz(32 * (et0 + t) + r32, (16 * ks + 8 * hi) * 2));
                acc[t] = __builtin_amdgcn_mfma_f32_32x32x16_bf16(a, vb, acc[t], 0, 0, 0); }
        }
        bf16_t* Uo = Ug + (size_t)it * 16384;
#pragma unroll
        for (int t = 0; t < 2; ++t)
#pragma unroll
            for (int g2 = 0; g2 < 2; ++g2) { const int e = 32 * (et0 + t) + r32;
                const unsigned a0 = pk2(acc[t][8 * g2], acc[t][8 * g2 + 1]), a1 = pk2(acc[t][8 * g2 + 2], acc[t][8 * g2 + 3]);
                const unsigned b0 = pk2(acc[t][8 * g2 + 4], acc[t][8 * g2 + 5]), b1 = pk2(acc[t][8 * g2 + 6], acc[t][8 * g2 + 7]);
                const auto s0 = __builtin_amdgcn_permlane32_swap(a0, b0, false, false), s1 = __builtin_amdgcn_permlane32_swap(a1, b1, false, false);
                u32x4 o; o.x = s0[0]; o.y = s1[0]; o.z = s0[1]; o.w = s1[1];
                *(u32x4*)(Uo + e * 128 + 32 * I + 8 * (2 * g2 + hi)) = o; }
    }
}
DI void hgrn_phase_b(const Params& p) {
    using namespace hg;
    unsigned char* ws = p.ws;
    bf16_t* Ug = (bf16_t*)p.out; const float* dec = (const float*)(ws + OFF_DEC);
    const int gt = blockIdx.x * 512 + threadIdx.x, NGT = gridDim.x * 512;
    for (int vi = gt; vi < NB * NH * 2048; vi += NGT) {
        const int bh = vi >> 11, o = (vi & 2047) * 8, d0 = o & 127;
        float S[8];
#pragma unroll
        for (int j = 0; j < 8; ++j) S[j] = 0.f;
        u32x4* ptr = (u32x4*)(Ug + (size_t)bh * NCHUNK * 16384 + o);
        const float* dp = dec + (size_t)bh * NCHUNK * 128 + d0;
#pragma unroll 1
        for (int n0 = 0; n0 < NCHUNK - 1; n0 += 8) {
            u32x4 u[8]; f32x4 da[8], db[8];
#pragma unroll
            for (int k = 0; k < 8; ++k) { u[k] = ptr[(size_t)(n0 + k) * 2048]; da[k] = *(const f32x4*)(dp + (n0 + k) * 128); db[k] = *(const f32x4*)(dp + (n0 + k) * 128 + 4); }
#pragma unroll
            for (int k = 0; k < 8; ++k) {
                u32x4 wv; wv.x = pk2(S[0], S[1]); wv.y = pk2(S[2], S[3]); wv.z = pk2(S[4], S[5]); wv.w = pk2(S[6], S[7]);
                ptr[(size_t)(n0 + k) * 2048] = wv;
                S[0] = da[k][0] * S[0] + bf_lo(u[k].x); S[1] = da[k][1] * S[1] + bf_hi(u[k].x); S[2] = da[k][2] * S[2] + bf_lo(u[k].y); S[3] = da[k][3] * S[3] + bf_hi(u[k].y);
                S[4] = db[k][0] * S[4] + bf_lo(u[k].z); S[5] = db[k][1] * S[5] + bf_hi(u[k].z); S[6] = db[k][2] * S[6] + bf_lo(u[k].w); S[7] = db[k][3] * S[7] + bf_hi(u[k].w);
            }
        }
        u32x4 wv; wv.x = pk2(S[0], S[1]); wv.y = pk2(S[2], S[3]); wv.z = pk2(S[4], S[5]); wv.w = pk2(S[6], S[7]);
        ptr[(size_t)(NCHUNK - 1) * 2048] = wv;
    }
}
DI void hgrn_phase_c(const Params& p, LAS unsigned char* lds) {
    using namespace hg;
    unsigned char* ws = p.ws;
    const int tid = opaque_tid(), w = tid >> 6, lane = tid & 63, dgrp = lane & 15, rsub = lane >> 4, l15 = lane & 15, g4 = lane >> 4;
    const int wsc = __builtin_amdgcn_readfirstlane(w);
    LAS float* Wl = (LAS float*)(lds + OFF_W); LAS float* cv = (LAS float*)(lds + OFF_CV); LAS float* part = (LAS float*)(lds + OFF_PART);
    const bf16_t* Sg = (const bf16_t*)p.out;
    const bf16_t* Gt = (const bf16_t*)(ws + OFF_GATE); bf16_t* Og = (bf16_t*)(ws + OFF_ABUF);
    const f32x4 on = *(const f32x4*)(p.honorm + 16 * w + 4 * g4);
    u32x4 gnext[4];
    { const int it = blockIdx.x, n = it % NCHUNK, bh = it / NCHUNK, h = bh & 7, b = bh >> 3;
      load_g4((const bf16_t*)(ws + OFF_GF) + ((size_t)b * LP + 128 * n) * D + h * DH, w, dgrp, rsub, gnext); }
    for (int it = blockIdx.x; it < NITEMS; it += gridDim.x) {
        const int n = it % NCHUNK, bh = it / NCHUNK, h = bh & 7, b = bh >> 3;
        const size_t rowbase = ((size_t)b * LP + 128 * n) * D + h * DH;
        const bf16_t* Qg = (const bf16_t*)(ws + OFF_Q) + rowbase; const bf16_t* Kg = (const bf16_t*)(ws + OFF_K) + rowbase; const bf16_t* Vg = (const bf16_t*)(ws + OFF_V) + rowbase;
        const bf16_t* St = Sg + (size_t)it * 16384;
        u32x4 graw[4];
#pragma unroll
        for (int rr = 0; rr < 4; ++rr) graw[rr] = gnext[rr];
        const int row0 = 16 * w + 4 * rsub;
        u32x4 qw[4], kw[4];
#pragma unroll
        for (int rr = 0; rr < 4; ++rr) { qw[rr] = *(const u32x4*)(Qg + (size_t)(row0 + rr) * D + 8 * dgrp); kw[rr] = *(const u32x4*)(Kg + (size_t)(row0 + rr) * D + 8 * dgrp); }
        __syncthreads();
        float bb[4][8], blast[8];
        cumsum4x8(graw, w, dgrp, rsub, Wl, bb, blast);
        { const int nx = it + (int)gridDim.x;
          if (nx < NITEMS) { const int n2 = nx % NCHUNK, bh2 = nx / NCHUNK, h2 = bh2 & 7, b2 = bh2 >> 3;
              load_g4((const bf16_t*)(ws + OFF_GF) + ((size_t)b2 * LP + 128 * n2) * D + h2 * DH, w, dgrp, rsub, gnext); } }
        float cc[8];
#pragma unroll
        for (int j = 0; j < 8; ++j) cc[j] = __shfl(bb[0][j], 32 + dgrp);
        if (rsub == 2) { *(LAS f32x4*)(cv + w * 128 + 8 * dgrp) = (f32x4){bb[0][0], bb[0][1], bb[0][2], bb[0][3]}; *(LAS f32x4*)(cv + w * 128 + 8 * dgrp + 4) = (f32x4){bb[0][4], bb[0][5], bb[0][6], bb[0][7]}; }
        float ec[8];
#pragma unroll
        for (int j = 0; j < 8; ++j) ec[j] = __builtin_amdgcn_exp2f(cc[j]);
        u32x4 qe[4];
#pragma unroll
        for (int rr = 0; rr < 4; ++rr) {
            float qp[8], kp[8], qx[8];
#pragma unroll
            for (int j = 0; j < 8; ++j) { const float qv = bf_at(qw[rr], j), kv = bf_at(kw[rr], j);
                const float t = __builtin_amdgcn_exp2f(__builtin_amdgcn_fmed3f(bb[rr][j] - cc[j], -115.f, 115.f));
                qp[j] = qv * t; kp[j] = kv * __builtin_amdgcn_rcpf(t); qx[j] = qp[j] * ec[j]; }
            u32x4 a; a.x = pk2(qp[0], qp[1]); a.y = pk2(qp[2], qp[3]); a.z = pk2(qp[4], qp[5]); a.w = pk2(qp[6], qp[7]);
            u32x4 c; c.x = pk2(kp[0], kp[1]); c.y = pk2(kp[2], kp[3]); c.z = pk2(kp[4], kp[5]); c.w = pk2(kp[6], kp[7]);
            *(LAS u32x4*)(lds + R1 + (row0 + rr) * RS + dgrp * 16) = a;
            *(LAS u32x4*)(lds + R2 + (row0 + rr) * RS + dgrp * 16) = c;
            qe[rr].x = pk2(qx[0], qx[1]); qe[rr].y = pk2(qx[2], qx[3]); qe[rr].z = pk2(qx[4], qx[5]); qe[rr].w = pk2(qx[6], qx[7]);
        }
        __syncthreads();
        bf16x8 sf[4]; u32x4 vw[4];
#pragma unroll
        for (int ks = 0; ks < 4; ++ks) sf[ks] = *(const bf16x8*)(St + (16 * w + l15) * 128 + 32 * ks + 8 * g4);
#pragma unroll
        for (int rr = 0; rr < 4; ++rr) vw[rr] = *(const u32x4*)(Vg + (size_t)(row0 + rr) * D + 8 * dgrp);
        {
            LAS float* et = (LAS float*)(lds + OFF_ET);
            const int dd = tid & 127;
#pragma unroll
            for (int k = 0; k < 7; ++k) {
                const int pid = (wsc >> 1) + 4 * k;
                int i = 1; while ((i + 1) * i / 2 <= pid) ++i;
                const int j = pid - i * (i - 1) / 2;
                et[pid * 128 + dd] = __builtin_amdgcn_exp2f(cv[i * 128 + dd] - cv[j * 128 + dd]);
            }
        }
        __syncthreads();
        {
            int cnt = 0;
            for (int i = 0; i < 8; ++i)
                for (int j = 0; j <= i; ++j, ++cnt) {
                    if ((cnt & 7) != wsc) continue;
                    f32x4 acc = (f32x4){0.f, 0.f, 0.f, 0.f};
#pragma unroll
                    for (int ks = 0; ks < 4; ++ks) {
                        const bf16x8 kf = *(LAS const bf16x8*)(lds + R2 + (16 * j + l15) * RS + (32 * ks + 8 * g4) * 2);
                        bf16x8 qf = *(LAS const bf16x8*)(lds + R1 + (16 * i + l15) * RS + (32 * ks + 8 * g4) * 2);
                        if (i != j) {
                            LAS const float* ep = (LAS const float*)(lds + OFF_ET) + (i * (i - 1) / 2 + j) * 128 + 32 * ks + 8 * g4;
                            const f32x4 e0 = *(LAS const f32x4*)ep, e1 = *(LAS const f32x4*)(ep + 4);
                            const u32x4 qq = __builtin_bit_cast(u32x4, qf);
                            u32x4 ow;
                            ow.x = pk2(bf_lo(qq.x) * e0[0], bf_hi(qq.x) * e0[1]);
                            ow.y = pk2(bf_lo(qq.y) * e0[2], bf_hi(qq.y) * e0[3]);
                            ow.z = pk2(bf_lo(qq.z) * e1[0], bf_hi(qq.z) * e1[1]);
                            ow.w = pk2(bf_lo(qq.w) * e1[2], bf_hi(qq.w) * e1[3]);
                            qf = __builtin_bit_cast(bf16x8, ow);
                        }
                        acc = __builtin_amdgcn_mfma_f32_16x16x32_bf16(kf, qf, acc, 0, 0, 0);
                    }
                    if (i == j) {
#pragma unroll
                        for (int jj = 0; jj < 4; ++jj) acc[jj] = (4 * g4 + jj <= l15) ? acc[jj] : 0.f;
                    }
                    u32x2 o; o.x = pk2(acc[0], acc[1]); o.y = pk2(acc[2], acc[3]);
                    *(LAS u32x2*)(lds + R3 + (16 * i + l15) * RS + (16 * j + 4 * g4) * 2) = o;
                }
            if (wsc < 4) { const int i = 2 * wsc, j = i + 1; *(LAS u32x2*)(lds + R3 + (16 * i + l15) * RS + (16 * j + 4 * g4) * 2) = (u32x2){0u, 0u}; }
        }
        __syncthreads();
#pragma unroll
        for (int rr = 0; rr < 4; ++rr) *(LAS u32x4*)(lds + R1 + (row0 + rr) * RS + dgrp * 16) = qe[rr];
#pragma unroll
        for (int j = 0; j < 8; ++j) { u32x2 vv; vv.x = bf_get(vw[0], j) | (bf_get(vw[1], j) << 16); vv.y = bf_get(vw[2], j) | (bf_get(vw[3], j) << 16);
            *(LAS u32x2*)(lds + R2 + tswz(8 * dgrp + j, row0 * 2)) = vv; }
        __syncthreads();
        const int rbase = n ? b * SEQ + 128 * (n - 1) + l15 : MMAIN + b * NMETA + l15 - 112;
        const size_t obase = (size_t)rbase * D + h * DH + 16 * w + 4 * g4;
        u32x2 gwv[8];
#pragma unroll
        for (int i = 0; i < 8; ++i) gwv[i] = *(const u32x2*)(Gt + (n || i == 7 ? obase + (size_t)(16 * i) * D : 0));
        f32x4 acc[8];
        {
            bf16x8 vf[4];
#pragma unroll
            for (int m = 0; m < 4; ++m) vf[m] = *(LAS const bf16x8*)(lds + R2 + tswz(16 * w + l15, (32 * m + 8 * g4) * 2));
#pragma unroll
            for (int i = 0; i < 8; ++i) {
                acc[i] = (f32x4){0.f, 0.f, 0.f, 0.f};
#pragma unroll
                for (int m = 0; m <= (i >> 1); ++m) { const bf16x8 bfr = *(LAS const bf16x8*)(lds + R3 + (16 * i + l15) * RS + (32 * m + 8 * g4) * 2);
                    acc[i] = __builtin_amdgcn_mfma_f32_16x16x32_bf16(vf[m], bfr, acc[i], 0, 0, 0); }
#pragma unroll
                for (int ks = 0; ks < 4; ++ks) { const bf16x8 bfr = *(LAS const bf16x8*)(lds + R1 + (16 * i + l15) * RS + (32 * ks + 8 * g4) * 2);
                    acc[i] = __builtin_amdgcn_mfma_f32_16x16x32_bf16(sf[ks], bfr, acc[i], 0, 0, 0); }
            }
            __builtin_amdgcn_sched_group_barrier(0x100, 8, 0);
#pragma unroll
            for (int k = 0; k < 52; ++k) { __builtin_amdgcn_sched_group_barrier(0x008, 1, 0); __builtin_amdgcn_sched_group_barrier(0x100, 1, 0); }
#pragma unroll
            for (int i = 0; i < 8; ++i) { float sq = (acc[i][0] * acc[i][0] + acc[i][1] * acc[i][1]) + (acc[i][2] * acc[i][2] + acc[i][3] * acc[i][3]);
                sq += __shfl_xor(sq, 16); sq += __shfl_xor(sq, 32);
                if (g4 == 0) part[(16 * i + l15) * 8 + w] = sq; }
        }
        __syncthreads();
#pragma unroll
        for (int i = 0; i < 8; ++i) {
            const f32x4 pa = *(LAS const f32x4*)(part + (16 * i + l15) * 8), pb = *(LAS const f32x4*)(part + (16 * i + l15) * 8 + 4);
            const float tot = ((pa[0] + pa[1]) + (pa[2] + pa[3])) + ((pb[0] + pb[1]) + (pb[2] + pb[3]));
            const float rs = rsqrtf(tot * (1.f / 128.f) + EPS);
            if (n || i == 7) {
                const size_t ob = obase + (size_t)(16 * i) * D;
                const u32x2 gw = gwv[i];
                u32x2 o; o.x = pk2(acc[i][0] * rs * on[0] * bf_lo(gw.x), acc[i][1] * rs * on[1] * bf_hi(gw.x));
                o.y = pk2(acc[i][2] * rs * on[2] * bf_lo(gw.y), acc[i][3] * rs * on[3] * bf_hi(gw.y));
                *(u32x2*)(Og + ob) = o;
            }
        }
    }
}

namespace sba {
typedef float f32x16 __attribute__((ext_vector_type(16)));
typedef short s16x4 __attribute__((ext_vector_type(4)));
#define KSWZ(row, colB) ((row) * 256 + ((colB) ^ (((row) & 7) << 4)))
DI int crow(int r, int hi) { return (r & 3) + 8 * (r >> 2) + 4 * hi; }
DI void qkt(f32x16& p0, f32x16& p1, LAS const unsigned char* Ks, const bf16x8* qr, int r32, int hi) {
    p0 = f32x16{}; p1 = f32x16{};
#pragma unroll
    for (int d0 = 0; d0 < 8; ++d0) { const int cb = (d0 * 16 + hi * 8) * 2;
        const bf16x8 b0 = *(LAS const bf16x8*)(Ks + KSWZ(r32, cb));
        const bf16x8 b1 = *(LAS const bf16x8*)(Ks + KSWZ(32 + r32, cb));
        p0 = __builtin_amdgcn_mfma_f32_32x32x16_bf16(b0, qr[d0], p0, 0, 0, 0);
        p1 = __builtin_amdgcn_mfma_f32_32x32x16_bf16(b1, qr[d0], p1, 0, 0, 0); }
    __builtin_amdgcn_sched_group_barrier(0x100, 6, 0);
#pragma unroll
    for (int k = 0; k < 16; ++k) { __builtin_amdgcn_sched_group_barrier(0x008, 1, 0); __builtin_amdgcn_sched_group_barrier(0x100, 1, 0); }
}
DI int v_st(int k, int c) { const int kk = (k & ~0xC) | ((k & 4) << 1) | ((k & 8) >> 1); return ((kk >> 3) * 4 + (c >> 5)) * 512 + ((kk & 7) * 32 + (c & 31)) * 2; }
DI int v_rd_base(int lane) { return ((lane & 3) << 3) | (((lane >> 2) & 3) << 6) | (((lane >> 4) & 1) << 5) | (((lane >> 5) & 1) << 8); }
constexpr int v_rd_off(int d0, int ks, int half) { return d0 * 512 + ks * 4096 + half * 2048; }
template <int OFF> DI s16x4 tr_read(int vb) { s16x4 r; asm volatile("ds_read_b64_tr_b16 %0, %1 offset:%2" : "=&v"(r) : "v"(vb), "i"(OFF) : "memory"); return r; }
template <int D0> DI void pv_one(f32x16& od, int vb, bf16x8 pa0, bf16x8 pa1, bf16x8 pa2, bf16x8 pa3) {
    const s16x4 l0 = tr_read<v_rd_off(D0, 0, 0)>(vb), h0 = tr_read<v_rd_off(D0, 0, 1)>(vb), l1 = tr_read<v_rd_off(D0, 1, 0)>(vb), h1 = tr_read<v_rd_off(D0, 1, 1)>(vb);
    const s16x4 l2 = tr_read<v_rd_off(D0, 2, 0)>(vb), h2 = tr_read<v_rd_off(D0, 2, 1)>(vb), l3 = tr_read<v_rd_off(D0, 3, 0)>(vb), h3 = tr_read<v_rd_off(D0, 3, 1)>(vb);
    asm volatile("s_waitcnt lgkmcnt(0)" ::: "memory"); __builtin_amdgcn_sched_barrier(0);
#define PK(Lx, Hx) (bf16x8){Lx[0], Lx[1], Lx[2], Lx[3], Hx[0], Hx[1], Hx[2], Hx[3]}
    od = __builtin_amdgcn_mfma_f32_32x32x16_bf16(pa0, PK(l0, h0), od, 0, 0, 0);
    od = __builtin_amdgcn_mfma_f32_32x32x16_bf16(pa1, PK(l1, h1), od, 0, 0, 0);
    od = __builtin_amdgcn_mfma_f32_32x32x16_bf16(pa2, PK(l2, h2), od, 0, 0, 0);
    od = __builtin_amdgcn_mfma_f32_32x32x16_bf16(pa3, PK(l3, h3), od, 0, 0, 0);
#undef PK
}
template <bool MASK>
DI void to_keep(f32x16& pz, int qrel  , int kmin  ) {
#pragma unroll
    for (int r = 0; r < 16; ++r) {
        const int kc = (r & 3) + 8 * (r >> 2);
        const float e = __builtin_amdgcn_exp2f(pz[r]);
        const float kp = __builtin_amdgcn_rcpf(1.f + e);
        pz[r] = (!MASK || (kc < qrel && kc >= kmin)) ? kp : 1.f;
    }
}
}

DI void attn_phase(const Params& p, LAS unsigned char* lds) {
    using namespace sba;
    unsigned char* ws = p.ws;
    const int tid = opaque_tid(), wid = tid >> 6, lane = tid & 63, r32 = lane & 31, hi = lane >> 5;
    LAS unsigned char* V_lds = lds; LAS unsigned char* K_lds = lds + 16384; LAS int* flags = (LAS int*)(lds + 32768);
    const int sr = tid >> 4, sc = (tid & 15) * 8, vst0 = v_st(sr, sc), vst1 = v_st(32 + sr, sc);
    const int vb0 = (int)(unsigned)(uintptr_t)V_lds + v_rd_base(lane);
    const bf16_t* Qg = (const bf16_t*)(ws + OFF_Q); const bf16_t* Kg = (const bf16_t*)(ws + OFF_K); const bf16_t* Vg = (const bf16_t*)(ws + OFF_V);
    const bf16_t* Gt = (const bf16_t*)(ws + OFF_GATE); bf16_t* Og = (bf16_t*)(ws + OFF_ABUF);
    constexpr int NQB = 17;
    for (int it = blockIdx.x; it < NB * NH * NQB; it += gridDim.x) {
        const int qb = it < NB * NH * (NQB - 1) ? 1 + (it & 15) : 0, bh = it < NB * NH * (NQB - 1) ? it >> 4 : it - NB * NH * (NQB - 1), h = bh & 7, b = bh >> 3;
        const int p0 = 256 * qb - 128, pw0 = p0 + 32 * wid, pq = pw0 + r32;
        const bf16_t* Kh = Kg + (size_t)b * LP * D + h * DH; const bf16_t* Vh = Vg + (size_t)b * LP * D + h * DH;
        const bf16_t* Qw = Qg + ((size_t)b * LP + (pq < 0 ? 0 : pq)) * D + h * DH + hi * 8;
        bf16x8 qr[8];
#pragma unroll
        for (int d0 = 0; d0 < 8; ++d0) { const u32x4 qv = *(const u32x4*)(Qw + d0 * 16); constexpr float C = SB_SCALE * 1.4426950408889634f;
            u32x4 qs; qs.x = pk2(bf_lo(qv.x) * C, bf_hi(qv.x) * C); qs.y = pk2(bf_lo(qv.y) * C, bf_hi(qv.y) * C); qs.z = pk2(bf_lo(qv.z) * C, bf_hi(qv.z) * C); qs.w = pk2(bf_lo(qv.w) * C, bf_hi(qv.w) * C);
            qr[d0] = __builtin_bit_cast(bf16x8, qs); }
        f32x16 o[4];
#pragma unroll
        for (int d0 = 0; d0 < 4; ++d0) o[d0] = f32x16{};
        float carry = 1.f;
        const bool wave_real = (pw0 + 31 >= NPAD);
        bool walive = wave_real;
        const int kt_hi = (p0 + 192) >> 6;
        bf16x8 v0, v1, k0, k1;
        { const size_t g0 = (size_t)(64 * kt_hi + sr) * D + sc, g1 = g0 + (size_t)32 * D;
          v0 = *(const bf16x8*)(Vh + g0); v1 = *(const bf16x8*)(Vh + g1); k0 = *(const bf16x8*)(Kh + g0); k1 = *(const bf16x8*)(Kh + g1); }
        for (int kt = kt_hi; kt >= 1; --kt) {
            __syncthreads();
            if (kt != kt_hi) {
                int any = 0;
#pragma unroll
                for (int w = 0; w < 8; ++w) any |= flags[w];
                if (!any) break;
            }
            *(LAS bf16x8*)(V_lds + vst0) = v0; *(LAS bf16x8*)(V_lds + vst1) = v1;
            *(LAS bf16x8*)(K_lds + KSWZ(sr, sc * 2)) = k0; *(LAS bf16x8*)(K_lds + KSWZ(32 + sr, sc * 2)) = k1;
            if (kt > 1) { const size_t g0 = (size_t)(64 * (kt - 1) + sr) * D + sc, g1 = g0 + (size_t)32 * D;
                v0 = *(const bf16x8*)(Vh + g0); v1 = *(const bf16x8*)(Vh + g1); k0 = *(const bf16x8*)(Kh + g0); k1 = *(const bf16x8*)(Kh + g1); }
            __syncthreads();
            if (walive && (64 * kt <= pw0 + 30)) {
                f32x16 z0, z1;
                qkt(z0, z1, K_lds, qr, r32, hi);
                const int qrel = pq - 64 * kt - 4 * hi, kmin = NPAD - 64 * kt - 4 * hi;
                if (64 * kt + 63 >= pw0 || kt == 1) { to_keep<true>(z0, qrel, kmin); to_keep<true>(z1, qrel - 32, kmin - 32); }
                else { to_keep<false>(z0, qrel, kmin); to_keep<false>(z1, qrel - 32, kmin - 32); }
                float glo[8], ghi[8];
#pragma unroll
                for (int i = 0; i < 8; ++i) {
                    const float g = i < 4 ? (z0[4 * i] * z0[4 * i + 1]) * (z0[4 * i + 2] * z0[4 * i + 3]) : (z1[4 * i - 16] * z1[4 * i - 15]) * (z1[4 * i - 14] * z1[4 * i - 13]);
                    auto rr = __builtin_amdgcn_permlane32_swap(__float_as_uint(g), __float_as_uint(g), false, false);
                    glo[i] = __uint_as_float(rr[0]); ghi[i] = __uint_as_float(rr[1]);
                }
                float R = carry;
#pragma unroll
                for (int i = 7; i >= 0; --i) {
                    float lat = hi ? R : R * ghi[i];
                    if (i >= 4) {
#pragma unroll
                        for (int j = 3; j >= 0; --j) { const float ln = lat * z1[4 * i - 16 + j]; z1[4 * i - 16 + j] = lat - ln; lat = ln; }
                    } else {
#pragma unroll
                        for (int j = 3; j >= 0; --j) { const float ln = lat * z0[4 * i + j]; z0[4 * i + j] = lat - ln; lat = ln; }
                    }
                    R = R * (glo[i] * ghi[i]);
                }
                carry = R;
                bf16x8 pa0, pa1, pa2, pa3;
#define PK4(P, BASE, OUT) do { unsigned a0 = pk2(P[BASE + 0], P[BASE + 1]), a1 = pk2(P[BASE + 2], P[BASE + 3]);   \
    unsigned b0 = pk2(P[BASE + 4], P[BASE + 5]), b1 = pk2(P[BASE + 6], P[BASE + 7]);                              \
    auto r0 = __builtin_amdgcn_permlane32_swap(a0, b0, false, false); auto r1 = __builtin_amdgcn_permlane32_swap(a1, b1, false, false); \
    u32x4 w = {r0[0], r1[0], r0[1], r1[1]}; OUT = *reinterpret_cast<bf16x8*>(&w); } while (0)
                PK4(z0, 0, pa0); PK4(z0, 8, pa1); PK4(z1, 0, pa2); PK4(z1, 8, pa3);
#undef PK4
                pv_one<0>(o[0], vb0, pa0, pa1, pa2, pa3); pv_one<1>(o[1], vb0, pa0, pa1, pa2, pa3); pv_one<2>(o[2], vb0, pa0, pa1, pa2, pa3); pv_one<3>(o[3], vb0, pa0, pa1, pa2, pa3);
            }
            {
                walive = wave_real && __any((carry > 0.f) && (pq >= NPAD));
                if (lane == 0) flags[wid] = walive ? 1 : 0;
            }
        }
        {
            LAS unsigned char* ot = lds + 40960 + wid * (32 * 272);
#pragma unroll
            for (int r = 0; r < 16; ++r)
#pragma unroll
                for (int d0 = 0; d0 < 4; ++d0) *(LAS bf16_t*)(ot + crow(r, hi) * 272 + (32 * d0 + r32) * 2) = (bf16_t)(pk2(o[d0][r], o[d0][r]) & 0xffffu);
#pragma unroll
            for (int k = 0; k < 8; ++k) {
                const int c = lane + 64 * k, row = c >> 4, ch = c & 15, pr = pw0 + row;
                if (pr >= NPAD) {
                    const u32x4 ov = *(LAS const u32x4*)(ot + row * 272 + ch * 16);
                    const size_t base = (size_t)row_of(b, pr - NPAD) * D + h * DH + ch * 8;
                    const u32x4 gv = *(const u32x4*)(Gt + base);
                    u32x4 w; w.x = pk2(bf_lo(ov.x) * bf_lo(gv.x), bf_hi(ov.x) * bf_hi(gv.x)); w.y = pk2(bf_lo(ov.y) * bf_lo(gv.y), bf_hi(ov.y) * bf_hi(gv.y));
                    w.z = pk2(bf_lo(ov.z) * bf_lo(gv.z), bf_hi(ov.z) * bf_hi(gv.z)); w.w = pk2(bf_lo(ov.w) * bf_lo(gv.w), bf_hi(ov.w) * bf_hi(gv.w));
                    *(u32x4*)(Og + base) = w;
                }
            }
        }
    }
}

DI void mid_phase(const Params& p) {
    unsigned char* ws = p.ws;
    const int tid = opaque_tid(), wave = tid >> 6, lane = tid & 63;
    const int gw = blockIdx.x * 8 + wave, NGW = gridDim.x * 8;
    f32x4 wpost[4], wpre[4];
#pragma unroll
    for (int j = 0; j < 4; ++j) { wpost[j] = ((const f32x4*)p.post)[lane + 64 * j]; wpre[j] = ((const f32x4*)(p.pre + D))[lane + 64 * j]; }
    u32x2 nyw[4]; f32x4 nhv[4];
    if (gw < M) { const u32x2* yr = (const u32x2*)((const bf16_t*)(ws + OFF_GF) + (size_t)gw * D); const f32x4* hr = (const f32x4*)h0_row(p, gw);
#pragma unroll
        for (int j = 0; j < 4; ++j) { nyw[j] = yr[lane + 64 * j]; nhv[j] = hr[lane + 64 * j]; } }
    for (int r = gw; r < M; r += NGW) {
        int b, l; bl_of(r, b, l);
        f32x4 y[4], hv[4]; float s = 0.f;
#pragma unroll
        for (int j = 0; j < 4; ++j) { const u32x2 yw = nyw[j]; y[j] = (f32x4){bf_lo(yw.x), bf_hi(yw.x), bf_lo(yw.y), bf_hi(yw.y)}; hv[j] = nhv[j]; }
        if (r + NGW < M) { const u32x2* yr = (const u32x2*)((const bf16_t*)(ws + OFF_GF) + (size_t)(r + NGW) * D); const f32x4* hr = (const f32x4*)h0_row(p, r + NGW);
#pragma unroll
            for (int j = 0; j < 4; ++j) { nyw[j] = yr[lane + 64 * j]; nhv[j] = hr[lane + 64 * j]; } }
#pragma unroll
        for (int j = 0; j < 4; ++j) s += (y[j][0] * y[j][0] + y[j][1] * y[j][1]) + (y[j][2] * y[j][2] + y[j][3] * y[j][3]);
        const float rs = rsqrtf(wave_sum(s) * (1.f / D) + EPS);
        float s1 = 0.f;
#pragma unroll
        for (int j = 0; j < 4; ++j) { hv[j] = hv[j] + y[j] * rs * wpost[j]; s1 += (hv[j][0] * hv[j][0] + hv[j][1] * hv[j][1]) + (hv[j][2] * hv[j][2] + hv[j][3] * hv[j][3]); }
        const float rs1 = rsqrtf(wave_sum(s1) * (1.f / D) + EPS);
        u32x2* o = (u32x2*)(ws + OFF_ABUF + (size_t)r * D * 2);
#pragma unroll
        for (int j = 0; j < 4; ++j) { u32x2 w; w.x = pk2(hv[j][0] * rs1 * wpre[j][0], hv[j][1] * rs1 * wpre[j][1]); w.y = pk2(hv[j][2] * rs1 * wpre[j][2], hv[j][3] * rs1 * wpre[j][3]); o[lane + 64 * j] = w; }
        if (l >= NMETA) { u32x2* hrow = (u32x2*)(ws + OFF_H1 + ((size_t)b * SEQ + (l - NMETA)) * D * 2);
#pragma unroll
            for (int j = 0; j < 4; ++j) { u32x2 hw; hw.x = pk2(hv[j][0], hv[j][1]); hw.y = pk2(hv[j][2], hv[j][3]); hrow[lane + 64 * j] = hw; } }
    }
}
DI void final_phase(const Params& p) {
    unsigned char* ws = p.ws;
    const int tid = opaque_tid(), wave = tid >> 6, lane = tid & 63;
    const int gw = blockIdx.x * 8 + wave, NGW = gridDim.x * 8;
    f32x4 wpost[4];
#pragma unroll
    for (int j = 0; j < 4; ++j) wpost[j] = ((const f32x4*)(p.post + D))[lane + 64 * j];
    u32x2 nyw[4], nhw[4];
    if (gw < NB * SEQ) { const u32x2* yr = (const u32x2*)((const bf16_t*)(ws + OFF_GF) + (size_t)gw * D); const u32x2* hrow = (const u32x2*)(ws + OFF_H1 + (size_t)gw * D * 2);
#pragma unroll
        for (int j = 0; j < 4; ++j) { nyw[j] = yr[lane + 64 * j]; nhw[j] = hrow[lane + 64 * j]; } }
    for (int r = gw; r < NB * SEQ; r += NGW) {
        f32x4* orow = (f32x4*)(p.out + (size_t)r * D);
        f32x4 y[4], hv[4]; float s = 0.f;
#pragma unroll
        for (int j = 0; j < 4; ++j) { const u32x2 yw = nyw[j]; y[j] = (f32x4){bf_lo(yw.x), bf_hi(yw.x), bf_lo(yw.y), bf_hi(yw.y)};
            const u32x2 hw = nhw[j]; hv[j] = (f32x4){bf_lo(hw.x), bf_hi(hw.x), bf_lo(hw.y), bf_hi(hw.y)}; }
        if (r + NGW < NB * SEQ) { const u32x2* yr = (const u32x2*)((const bf16_t*)(ws + OFF_GF) + (size_t)(r + NGW) * D); const u32x2* hrow = (const u32x2*)(ws + OFF_H1 + (size_t)(r + NGW) * D * 2);
#pragma unroll
            for (int j = 0; j < 4; ++j) { nyw[j] = yr[lane + 64 * j]; nhw[j] = hrow[lane + 64 * j]; } }
#pragma unroll
        for (int j = 0; j < 4; ++j) s += (y[j][0] * y[j][0] + y[j][1] * y[j][1]) + (y[j][2] * y[j][2] + y[j][3] * y[j][3]);
        const float rs = rsqrtf(wave_sum(s) * (1.f / D) + EPS);
#pragma unroll
        for (int j = 0; j < 4; ++j) orow[lane + 64 * j] = hv[j] + y[j] * rs * wpost[j];
    }
}


template <class F>
DI void meta_gemm(const bf16_t* A16, const bf16_t* Bt, int N, LAS unsigned char* lds, F&& store) {
    const int tid = opaque_tid(), wid = tid >> 6, lane = tid & 63, l15 = lane & 15, g4 = lane >> 4;
    LAS f32x4* red = (LAS f32x4*)lds;
    for (int t = blockIdx.x; t < N / 16; t += (int)gridDim.x) {
        f32x4 acc = (f32x4){0.f, 0.f, 0.f, 0.f};
        const bf16_t* bp = Bt + (size_t)(16 * t + l15) * 1024 + 8 * g4 + 128 * wid;
        const bf16_t* ap = A16 + (size_t)l15 * 1024 + 8 * g4 + 128 * wid;
#pragma unroll
        for (int ks = 0; ks < 4; ++ks) {
            const bf16x8 bf = *(const bf16x8*)(bp + 32 * ks), af = *(const bf16x8*)(ap + 32 * ks);
            acc = __builtin_amdgcn_mfma_f32_16x16x32_bf16(bf, af, acc, 0, 0, 0);
        }
        red[wid * 64 + lane] = acc;
        __syncthreads();
        if (wid == 0) {
#pragma unroll
            for (int w2 = 1; w2 < 8; ++w2) acc += red[w2 * 64 + lane];
            store(l15, 16 * t + 4 * g4, acc);
        }
        __syncthreads();
    }
}
DI void meta_proj(const Params& p, const bf16_t* Bt, int mode, LAS unsigned char* lds) {
    unsigned char* ws = p.ws;
    bf16_t* Q = (bf16_t*)(ws + OFF_Q); bf16_t* Gate = (bf16_t*)(ws + OFF_GATE); bf16_t* Gh = (bf16_t*)(ws + OFF_GF); const float* lb = (const float*)(ws + OFF_LB);
    meta_gemm((const bf16_t*)(ws + OFF_ABUF) + (size_t)MMAIN * D, Bt, 4096, lds, [&](int l, int c0, f32x4 v) {
        const int sec = c0 >> 10, cc = c0 & 1023;
        if (sec == 3) {
#pragma unroll
            for (int j = 0; j < 4; ++j) v[j] = v[j] * sigmoidf_(v[j]);
            u32x2 w; w.x = pk2(v[0], v[1]); w.y = pk2(v[2], v[3]);
            for (int b = 0; b < NB; ++b) *(u32x2*)(Gate + (size_t)row_of(b, l) * D + cc) = w;
        } else if (sec == 1 && mode == 0) {
            const f32x4 lbv = *(const f32x4*)(lb + cc);
            float g[4];
#pragma unroll
            for (int j = 0; j < 4; ++j) { const float e = __expf(fminf(-v[j], 80.f)), sg = __builtin_amdgcn_rcpf(1.f + e), sn = e * sg; g[j] = __builtin_amdgcn_logf(lbv[j] + (1.f - lbv[j]) * sg); v[j] = (1.f - lbv[j]) * sn; }
            u32x2 w; w.x = pk2(v[0], v[1]); w.y = pk2(v[2], v[3]);
            u32x2 gw; gw.x = pkh2(g[0], g[1]); gw.y = pkh2(g[2], g[3]);
            for (int b = 0; b < NB; ++b) { const size_t o = ((size_t)b * LP + NPAD + l) * D + cc; *(u32x2*)(Q + (size_t)NB * LP * D + o) = w; *(u32x2*)(Gh + o) = gw; }
        } else {
            u32x2 w; w.x = pk2(v[0], v[1]); w.y = pk2(v[2], v[3]);
            bf16_t* dst = Q + (size_t)sec * ((size_t)NB * LP * D);
            for (int b = 0; b < NB; ++b) *(u32x2*)(dst + ((size_t)b * LP + NPAD + l) * D + cc) = w;
        }
    });
}
DI void meta_out(const Params& p, const bf16_t* Bt, LAS unsigned char* lds) {
    unsigned char* ws = p.ws;
    bf16_t* Y = (bf16_t*)(ws + OFF_GF);
    meta_gemm((const bf16_t*)(ws + OFF_ABUF) + (size_t)MMAIN * D, Bt, 1024, lds, [&](int l, int c0, f32x4 v) {
        u32x2 w; w.x = pk2(v[0], v[1]); w.y = pk2(v[2], v[3]);
        for (int b = 0; b < NB; ++b) *(u32x2*)(Y + (size_t)row_of(b, l) * D + c0) = w;
    });
}

#define XB_TMO      128
#define XB_XCNT(j)  (256  + 64 * (j))
#define XB_XSUB(j)  (1280 + 64 * (j))
#define XB_XGEN(j)  (2304 + 64 * (j))
#define XB_TOP      3328
#define XB_TOPGEN   3392
#define XCD_BAR_WORDS 3456
#define XB_SPIN_CAP (1u << 20)
DI unsigned xb_ld(unsigned* p)              { return __hip_atomic_load(p, __ATOMIC_RELAXED, __HIP_MEMORY_SCOPE_AGENT); }
DI unsigned xb_add(unsigned* p, unsigned v) { return __hip_atomic_fetch_add(p, v, __ATOMIC_RELAXED, __HIP_MEMORY_SCOPE_AGENT); }
DI unsigned xb_xcc_id() { return (unsigned)__builtin_amdgcn_s_getreg((3 << 11) | 20) & 0xFu; }
#define XB_SPIN(cond, bar) do { unsigned _sp = 0; while (cond) { __builtin_amdgcn_s_sleep(1); \
    if ((++_sp & 255u) == 0u) { if (xb_ld(&(bar)[XB_TMO])) break; if (_sp > XB_SPIN_CAP) { atomicAdd(&(bar)[XB_TMO], 1u); break; } } } } while (0)
struct XcdBarrier { unsigned* bar; unsigned x; volatile LAS unsigned* st; };
DI XcdBarrier xcd_barrier_post(unsigned* bar, volatile LAS unsigned* st) {
    XcdBarrier b; b.bar = bar; b.x = xb_xcc_id(); b.st = st;
    if (threadIdx.x == 0) (void)xb_add(&bar[XB_XCNT(b.x)], 1u);
    return b;
}
DI void xcd_barrier_complete(unsigned* bar, unsigned x, unsigned& nloc, unsigned& nx) {
    const unsigned G = gridDim.x * gridDim.y * gridDim.z;
    unsigned sum, cnt, mine, sp = 0u;
    for (;;) {
        sum = 0u; cnt = 0u; mine = 0u;
#pragma unroll
        for (unsigned j = 0; j < 16; ++j) { const unsigned c = xb_ld(&bar[XB_XCNT(j)]); sum += c; cnt += (c > 0u) ? 1u : 0u; mine = (j == x) ? c : mine; }
        if (sum == G) break;
        __builtin_amdgcn_s_sleep(1);
        if ((++sp & 255u) == 0u) { if (xb_ld(&bar[XB_TMO])) break; if (sp > XB_SPIN_CAP) { atomicAdd(&bar[XB_TMO], 1u); break; } }
    }
    nloc = mine > 0u ? mine : 1u; nx = cnt > 0u ? cnt : 1u;
}
DI void xcd_barrier(const XcdBarrier& b) {
    asm volatile("s_waitcnt vmcnt(0)" ::: "memory");
    __syncthreads();
    if (threadIdx.x == 0) {
        unsigned* bar = b.bar;
        __builtin_amdgcn_s_waitcnt(0);
        unsigned nloc = b.st[0], nx = b.st[1];
        if (nloc == 0u) { xcd_barrier_complete(bar, b.x, nloc, nx); b.st[0] = nloc; b.st[1] = nx; }
        const unsigned old = xb_add(&bar[XB_XSUB(b.x)], 1u);
        const unsigned gen = old / nloc;
        if (old + 1u == (gen + 1u) * nloc) {
            __builtin_amdgcn_fence(__ATOMIC_RELEASE, "agent");
            asm volatile("s_waitcnt vmcnt(0)" ::: "memory");
            const unsigned og = xb_add(&bar[XB_TOP], 1u);
            const unsigned tg = og / nx;
            if (og + 1u == (tg + 1u) * nx) xb_add(&bar[XB_TOPGEN], 1u);
            else XB_SPIN(xb_ld(&bar[XB_TOPGEN]) == tg, bar);
            __builtin_amdgcn_fence(__ATOMIC_ACQUIRE, "agent");
            xb_add(&bar[XB_XGEN(b.x)], 1u);
            asm volatile("s_waitcnt vmcnt(0)" ::: "memory");
        } else {
            XB_SPIN(xb_ld(&bar[XB_XGEN(b.x)]) == gen, bar);
            __builtin_amdgcn_fence(__ATOMIC_ACQUIRE, "agent");
            asm volatile("s_waitcnt vmcnt(0)" ::: "memory");
        }
    }
    __syncthreads();
}

__global__ __launch_bounds__(512, 2) void mega_fwd(Params p) {
    extern __shared__ __attribute__((aligned(16))) unsigned char shm[];
    LAS unsigned char* lds = (LAS unsigned char*)shm;
    cg::grid_group grid = cg::this_grid();
    unsigned char* ws = p.ws;
    pg8::StaticOrder S;

    unsigned* barw = (unsigned*)(ws + OFF_BAR);
    volatile LAS unsigned* xst = (volatile LAS unsigned*)(lds + 131072);
    if (blockIdx.x == 0) for (int i = threadIdx.x; i < XCD_BAR_WORDS; i += 512) barw[i] = 0u;
    if (threadIdx.x == 0) { xst[0] = 0u; xst[1] = 0u; }
    prep_phase(p, lds);
    grid.sync();
    const XcdBarrier xb = xcd_barrier_post(barw, xst);
    LAS float* lb_lds = (LAS float*)(lds + 131072 + 64);
    for (int i = threadIdx.x; i < 1024; i += 512) lb_lds[i] = ((const float*)(ws + OFF_LB))[i];
    __syncthreads();
    {
        meta_proj(p, (const bf16_t*)(ws + OFF_WT_IN0), 0, lds);
        pg8::Gemm g{(const bf16_t*)(ws + OFF_ABUF), (const bf16_t*)(ws + OFF_WT_IN0), MMAIN, 4096, 1024};
        pg8::EpiProj E{(bf16_t*)(ws + OFF_Q), (bf16_t*)(ws + OFF_K), (bf16_t*)(ws + OFF_V), (bf16_t*)(ws + OFF_GATE), (bf16_t*)(ws + OFF_GF), lb_lds, 0};
        S.init(MMAIN, 4096, (int)gridDim.x, (int)blockIdx.x);
        pg8::gemm_phase(lds, g, S, E);
    }
    xcd_barrier(xb);
    hgrn_phase_a(p, lds);
    xcd_barrier(xb);
    hgrn_phase_b(p);
    xcd_barrier(xb);
    hgrn_phase_c(p, lds);
    xcd_barrier(xb);
    {
        meta_out(p, (const bf16_t*)(ws + OFF_WT_OUT0), lds);
        pg8::Gemm g{(const bf16_t*)(ws + OFF_ABUF), (const bf16_t*)(ws + OFF_WT_OUT0), MMAIN, 1024, 1024};
        pg8::EpiBf16 E{(bf16_t*)(ws + OFF_GF), D};
        S.init(MMAIN, 1024, (int)gridDim.x, (int)blockIdx.x);
        pg8::gemm_phase(lds, g, S, E);
    }
    xcd_barrier(xb);
    mid_phase(p);
    xcd_barrier(xb);
    {
        meta_proj(p, (const bf16_t*)(ws + OFF_WT_IN1), 1, lds);
        pg8::Gemm g{(const bf16_t*)(ws + OFF_ABUF), (const bf16_t*)(ws + OFF_WT_IN1), MMAIN, 4096, 1024};
        pg8::EpiProj E{(bf16_t*)(ws + OFF_Q), (bf16_t*)(ws + OFF_K), (bf16_t*)(ws + OFF_V), (bf16_t*)(ws + OFF_GATE), (bf16_t*)(ws + OFF_GF), lb_lds, 1};
        S.init(MMAIN, 4096, (int)gridDim.x, (int)blockIdx.x);
        pg8::gemm_phase(lds, g, S, E);
    }
    xcd_barrier(xb);
    attn_phase(p, lds);
    xcd_barrier(xb);
    {
        pg8::Gemm g{(const bf16_t*)(ws + OFF_ABUF), (const bf16_t*)(ws + OFF_WT_OUT1), MMAIN, 1024, 1024};
        pg8::EpiBf16 E{(bf16_t*)(ws + OFF_GF), D};
        S.init(MMAIN, 1024, (int)gridDim.x, (int)blockIdx.x);
        pg8::gemm_phase(lds, g, S, E);
    }
    xcd_barrier(xb);
    final_phase(p);
}

constexpr int LDS_BYTES = 131072 + 64 + 4096;

extern "C" void kernel_launch(void* const* d_in, const int* in_sizes, int n_in, void* d_out, int out_size, void* d_ws, size_t ws_size, hipStream_t stream) {
    static int grid_blocks = 0;
    if (!grid_blocks) {
        int dev = 0, cus = 0, per_cu = 0;
        hipGetDevice(&dev);
        hipDeviceGetAttribute(&cus, hipDeviceAttributeMultiprocessorCount, dev);
        hipFuncSetAttribute((const void*)mega_fwd, hipFuncAttributeMaxDynamicSharedMemorySize, LDS_BYTES);
        hipOccupancyMaxActiveBlocksPerMultiprocessor(&per_cu, (const void*)mega_fwd, 512, LDS_BYTES);
        if (per_cu < 1) per_cu = 1;
        grid_blocks = cus * per_cu;
        if (ws_size < WS_END + (size_t)NB * NH * NCHUNK * 128 * 4) fprintf(stderr, "workspace too small: %zu\n", ws_size);
    }
    Params p{};
    p.x = (const float*)d_in[0]; p.meta = (const float*)d_in[1]; p.pre = (const float*)d_in[2]; p.post = (const float*)d_in[3];
    p.hw_in = (const float*)d_in[4]; p.hlb = (const float*)d_in[5]; p.honorm = (const float*)d_in[6]; p.hw_out = (const float*)d_in[7];
    p.sw_in = (const float*)d_in[8]; p.sw_out = (const float*)d_in[9];
    p.out = (float*)d_out; p.ws = (unsigned char*)d_ws;
    void* args[] = {&p};
    hipError_t e = hipLaunchCooperativeKernel((const void*)mega_fwd, dim3(grid_blocks), dim3(512), args, LDS_BYTES, stream);
    if (e != hipSuccess) fprintf(stderr, "cooperative launch failed: %s (grid %d)\n", hipGetErrorString(e), grid_blocks);
}
```
